# Optimizing an MI355X kernel written in HIP

```python
import math
import jax, jax.numpy as jnp
from jax import lax
import numpy as np

D_MODEL = 2048
BATCH = 2
SEQ = 16384
DEPTH = 2

D_MIX = D_MODEL
DIFF_WIDTH = D_MIX // 2
DIFF_HEAD_DIM = 128
DIFF_V_DIM = 2 * DIFF_HEAD_DIM
DIFF_HEADS = DIFF_WIDTH // DIFF_V_DIM
MLA_V = 128
MLA_HEADS = (D_MIX - DIFF_WIDTH) // MLA_V
MLA_NOPE = 128
MLA_ROPE = 64
Q_LORA = D_MODEL // 4
KV_LORA = D_MODEL // 8
D_FF = 4 * D_MODEL
NUM_BUCKETS = 32
MAX_DISTANCE = 128
ROPE_THETA = 10000.0
Q_BLOCK = 128
EPS = 1e-6

DIFF_Q_COLS = DIFF_HEADS * 2 * DIFF_HEAD_DIM
DIFF_K_COLS = DIFF_HEADS * 2 * DIFF_HEAD_DIM
DIFF_V_COLS = DIFF_HEADS * DIFF_V_DIM
OFF_DQ = 0
OFF_DK = OFF_DQ + DIFF_Q_COLS
OFF_DV = OFF_DK + DIFF_K_COLS
OFF_CQ = OFF_DV + DIFF_V_COLS
OFF_CKV = OFF_CQ + Q_LORA
OFF_KR = OFF_CKV + KV_LORA
IN_COLS = OFF_KR + MLA_ROPE

kernel_name = "hybrid_diffattn_mla_encoder"


def _rmsnorm(x, g=None):
    x32 = x.astype(jnp.float32)
    y = x32 * lax.rsqrt(jnp.mean(x32 * x32, axis=-1, keepdims=True) + EPS)
    y = y.astype(x.dtype)
    return y if g is None else y * g


def _lambda_init(layer_idx):
    return 0.8 - 0.6 * math.exp(-0.3 * (layer_idx - 1))


def _t5_bucket(rel):
    nb = NUM_BUCKETS // 2
    max_exact = nb // 2
    ret = jnp.where(rel > 0, nb, 0)
    n = jnp.abs(rel)
    nf = jnp.maximum(n, 1).astype(jnp.float32)
    large = max_exact + (jnp.log(nf / max_exact) / math.log(MAX_DISTANCE / max_exact)
                         * (nb - max_exact)).astype(jnp.int32)
    large = jnp.minimum(large, nb - 1)
    return ret + jnp.where(n < max_exact, n, large)


def _rope(x, cos, sin):
    half = x.shape[-1] // 2
    x1, x2 = x[..., :half], x[..., half:]
    out = jnp.concatenate([x1 * cos - x2 * sin, x2 * cos + x1 * sin], axis=-1)
    return out.astype(x.dtype)


def _diff_attention(q, k, v, positions, bias_table, lam, subln_g, lambda_init):
    B, S, H, _, d = q.shape
    dv = v.shape[-1]
    nblk = S // Q_BLOCK
    scale = 1.0 / math.sqrt(d)
    qb = q.reshape(B, nblk, Q_BLOCK, H, 2, d).transpose(1, 0, 3, 4, 2, 5)
    kt = k.transpose(0, 2, 3, 1, 4)
    vt = v.transpose(0, 2, 1, 3)
    pb = positions.reshape(B, nblk, Q_BLOCK).transpose(1, 0, 2)

    def block(args):
        qi, pi = args
        s = jnp.einsum('bhmqd,bhmkd->bhmqk', qi, kt).astype(jnp.float32) * scale
        rel = positions[:, None, :] - pi[:, :, None]
        bias = bias_table[_t5_bucket(rel)].astype(jnp.float32)
        bias = bias.transpose(0, 3, 1, 2)[:, :, None]
        p = jax.nn.softmax(s + bias, axis=-1)
        a = p[:, :, 0] - lam * p[:, :, 1]
        return jnp.einsum('bhqk,bhkd->bhqd', a.astype(vt.dtype), vt)

    o = lax.map(block, (qb, pb))
    o = o.transpose(1, 0, 3, 2, 4).reshape(B, S, H, dv)
    o = _rmsnorm(o, subln_g) * (1.0 - lambda_init)
    return o.reshape(B, S, H * dv)


def _mla_attention(q_nope, q_rope, k_nope, k_rope, v):
    B, S, H, dn = q_nope.shape
    dr = q_rope.shape[-1]
    dv = v.shape[-1]
    nblk = S // Q_BLOCK
    scale = 1.0 / math.sqrt(dn + dr)
    qnb = q_nope.reshape(B, nblk, Q_BLOCK, H, dn).transpose(1, 0, 3, 2, 4)
    qrb = q_rope.reshape(B, nblk, Q_BLOCK, H, dr).transpose(1, 0, 3, 2, 4)
    knt = k_nope.transpose(0, 2, 1, 3)
    vt = v.transpose(0, 2, 1, 3)

    def block(args):
        qn, qr = args
        s = (jnp.einsum('bhqd,bhkd->bhqk', qn, knt)
             + jnp.einsum('bhqr,bkr->bhqk', qr, k_rope)).astype(jnp.float32) * scale
        p = jax.nn.softmax(s, axis=-1)
        return jnp.einsum('bhqk,bhkd->bhqd', p.astype(vt.dtype), vt)

    o = lax.map(block, (qnb, qrb))
    return o.transpose(1, 0, 3, 2, 4).reshape(B, S, H * dv)


def setup_inputs(seed: int = 0) -> dict:
    key = jax.random.key(seed)
    ks = jax.random.split(key, 24)
    f32 = jnp.float32

    def nrm(k, shape, scale):
        return jax.random.normal(k, shape, f32) * scale

    x = jax.random.normal(ks[0], (BATCH, SEQ, D_MODEL), f32)
    c = jax.random.normal(ks[1], (BATCH, D_MODEL), f32)
    offset = jax.random.randint(ks[2], (BATCH,), 0, 1024, dtype=jnp.int32)
    positions = (offset[:, None] + jnp.arange(SEQ, dtype=jnp.int32)[None, :]).astype(jnp.int32)
    return {
        "x": x,
        "c": c,
        "positions": positions,
        "rel_bias_table": nrm(ks[3], (NUM_BUCKETS, DIFF_HEADS), 0.5),
        "w_ada": nrm(ks[4], (DEPTH, D_MODEL, 6 * D_MODEL), D_MODEL ** -0.5),
        "b_ada": nrm(ks[5], (DEPTH, 6 * D_MODEL), 0.02),
        "w_in": nrm(ks[6], (DEPTH, D_MODEL, IN_COLS), D_MODEL ** -0.5),
        "diff_lambda_q1": nrm(ks[7], (DEPTH, DIFF_HEAD_DIM), 0.1),
        "diff_lambda_k1": nrm(ks[8], (DEPTH, DIFF_HEAD_DIM), 0.1),
        "diff_lambda_q2": nrm(ks[9], (DEPTH, DIFF_HEAD_DIM), 0.1),
        "diff_lambda_k2": nrm(ks[10], (DEPTH, DIFF_HEAD_DIM), 0.1),
        "diff_subln_g": 1.0 + nrm(ks[11], (DEPTH, DIFF_V_DIM), 0.02),
        "q_norm_g": 1.0 + nrm(ks[12], (DEPTH, Q_LORA), 0.02),
        "w_uq": nrm(ks[13], (DEPTH, Q_LORA, MLA_HEADS * (MLA_NOPE + MLA_ROPE)), Q_LORA ** -0.5),
        "kv_norm_g": 1.0 + nrm(ks[14], (DEPTH, KV_LORA), 0.02),
        "w_ukv": nrm(ks[15], (DEPTH, KV_LORA, MLA_HEADS * (MLA_NOPE + MLA_V)), KV_LORA ** -0.5),
        "w_o": nrm(ks[16], (DEPTH, D_MIX, D_MODEL), D_MIX ** -0.5),
        "w_mlp_in": nrm(ks[17], (DEPTH, D_MODEL, D_FF), D_MODEL ** -0.5),
        "w_mlp_out": nrm(ks[18], (DEPTH, D_FF, D_MODEL), D_FF ** -0.5),
        "final_norm_g": 1.0 + nrm(ks[19], (D_MODEL,), 0.02),
    }


def reference(x, c, positions, rel_bias_table, w_ada, b_ada, w_in,
              diff_lambda_q1, diff_lambda_k1, diff_lambda_q2, diff_lambda_k2,
              diff_subln_g, q_norm_g, w_uq, kv_norm_g, w_ukv, w_o,
              w_mlp_in, w_mlp_out, final_norm_g):
    B, S, D = x.shape
    inv_freq = 1.0 / (ROPE_THETA ** (jnp.arange(0, MLA_ROPE, 2, dtype=jnp.float32) / MLA_ROPE))
    ang = positions.astype(jnp.float32)[..., None] * inv_freq
    cos, sin = jnp.cos(ang), jnp.sin(ang)
    cond = jax.nn.silu(c)

    for l in range(DEPTH):
        lambda_init = _lambda_init(l + 1)
        mod = cond @ w_ada[l] + b_ada[l]
        sh_a, sc_a, g_a, sh_m, sc_m, g_m = [m[:, None, :] for m in jnp.split(mod, 6, axis=-1)]

        h = _rmsnorm(x) * (1.0 + sc_a) + sh_a
        proj = h @ w_in[l]
        dq = proj[..., OFF_DQ:OFF_DK].reshape(B, S, DIFF_HEADS, 2, DIFF_HEAD_DIM)
        dk = proj[..., OFF_DK:OFF_DV].reshape(B, S, DIFF_HEADS, 2, DIFF_HEAD_DIM)
        dv = proj[..., OFF_DV:OFF_CQ].reshape(B, S, DIFF_HEADS, DIFF_V_DIM)
        cq = proj[..., OFF_CQ:OFF_CKV]
        ckv = proj[..., OFF_CKV:OFF_KR]
        kr = proj[..., OFF_KR:IN_COLS]

        lam = (jnp.exp(jnp.sum(diff_lambda_q1[l] * diff_lambda_k1[l]))
               - jnp.exp(jnp.sum(diff_lambda_q2[l] * diff_lambda_k2[l])) + lambda_init)
        out_a = _diff_attention(dq, dk, dv, positions, rel_bias_table, lam,
                                diff_subln_g[l], lambda_init)

        q = (_rmsnorm(cq, q_norm_g[l]) @ w_uq[l]).reshape(B, S, MLA_HEADS, MLA_NOPE + MLA_ROPE)
        q_nope = q[..., :MLA_NOPE]
        q_rope = _rope(q[..., MLA_NOPE:], cos[:, :, None, :], sin[:, :, None, :])
        kv = (_rmsnorm(ckv, kv_norm_g[l]) @ w_ukv[l]).reshape(B, S, MLA_HEADS, MLA_NOPE + MLA_V)
        k_nope, v_m = kv[..., :MLA_NOPE], kv[..., MLA_NOPE:]
        k_rope = _rope(kr, cos, sin)
        out_b = _mla_attention(q_nope, q_rope, k_nope, k_rope, v_m)

        mix = jnp.concatenate([out_a, out_b], axis=-1) @ w_o[l]
        x = x + g_a * mix

        h = _rmsnorm(x) * (1.0 + sc_m) + sh_m
        y = jnp.square(jax.nn.relu(h @ w_mlp_in[l])) @ w_mlp_out[l]
        x = x + g_m * y

    return _rmsnorm(x, final_norm_g)
```

```cpp
#include <hip/hip_runtime.h>
#include <hip/hip_cooperative_groups.h>
#include <cstdio>
#include <cstdint>
namespace cg = cooperative_groups;

#ifndef PROBE_DUP
#define PROBE_DUP 0
#endif
#ifndef PP_STAGGER
#define PP_STAGGER 0
#endif
#ifndef MK_N_LAUNCHES
#define MK_N_LAUNCHES 1
#endif

namespace pg8 {
#define PG8_LAS __attribute__((address_space(3)))
typedef unsigned short bf16_t;
typedef short bf16x8 __attribute__((ext_vector_type(8)));
typedef float f32x4 __attribute__((ext_vector_type(4)));
typedef unsigned u32x4 __attribute__((ext_vector_type(4)));
constexpr int BM = 256, BK = 64, HALF = 128, HTB = HALF * BK * 2, STAGE_BYTES = 8 * HTB, NXCD = 8, WGM = 8;

__host__ __device__ __forceinline__ int lds_byte(int r, int c) { const int st = (r >> 4) * 2 + (c >> 5), rr = r & 15, cc = c & 31, ob = rr * 64 + cc * 2; return st * 1024 + (ob ^ (((ob >> 9) & 1) << 5)); }
__host__ __device__ __forceinline__ void stage_rc(int b, int& R, int& C) { const int st = b / 1024, sb = b % 1024, swz = sb ^ (((sb >> 9) & 1) << 5); R = (st >> 1) * 16 + swz / 64; C = (st & 1) * 32 + (swz % 64) / 2; }
__host__ __device__ __forceinline__ int perm32(int rho) { const int n = rho >> 4, i = rho & 15; return 8 * (i >> 2) + 4 * n + (i & 3); }

struct Unit { int pm, pn; };
struct Gemm { const bf16_t* A; const bf16_t* Bt; int M, N, K; };

struct StaticOrder {
    int nM, nN, nwg, G, c;
    __host__ __device__ void init(int M, int N, int G_, int c_) { nM = M / BM; nN = N / BM; nwg = nM * nN; G = G_; c = c_; }
    __host__ __device__ bool next(int i, Unit& u) const {
        const long L = (long)i * G + c; if (L >= nwg) return false;
        int wgid = (int)L; { const int q = nwg / NXCD, r = nwg % NXCD, xcd = wgid % NXCD, off = wgid / NXCD; wgid = (xcd < r ? xcd * (q + 1) : r * (q + 1) + (xcd - r) * q) + off; }
        const int nig = WGM * nN, gid = wgid / nig, fm = gid * WGM, gsz = (nM - fm) < WGM ? (nM - fm) : WGM;
        u.pm = fm + ((wgid % nig) % gsz); u.pn = (wgid % nig) / gsz; return true;
    }
    __device__ __forceinline__ void a_ready(const Unit&) const {}
    __device__ __forceinline__ void done(const Unit&) const {}
};

__device__ __forceinline__ unsigned cvt_pk_bf16(float lo, float hi) { unsigned r; asm volatile("v_cvt_pk_bf16_f32 %0, %1, %2" : "=v"(r) : "v"(lo), "v"(hi)); return r; }

template <int ACT  , bool HM = false  > struct EpiBf16 {
    static constexpr bool PERM = true, AFTER_DRAIN = false;
    bf16_t* O; int ldc;
    __device__ __forceinline__ void operator()(const f32x4 (&acc)[2][2][4][2], const Unit& u, int wr, int wc, int fr, int fq) const {
        const int row0 = u.pm * BM + wr * 64 + fr; const int col0 = u.pn * BM + wc * 32 + 8 * fq;
#pragma unroll
        for (int ai = 0; ai < 2; ++ai)
#pragma unroll
            for (int m = 0; m < 4; ++m) { const int row = row0 + ai * HALF + m * 16;
                bf16_t* rowp = HM ? O + ((size_t)((row >> 14) * ldc + u.pn * 2) * 16384 + (row & 16383)) * 128 + wc * 32 + 8 * fq : O + (size_t)row * ldc + col0;
#pragma unroll
                for (int bj = 0; bj < 2; ++bj) { f32x4 v0 = acc[ai][bj][m][0], v1 = acc[ai][bj][m][1];
                    if (ACT == 2) {
#pragma unroll
                        for (int e = 0; e < 4; ++e) { const float a = fmaxf(v0[e], 0.f), b = fmaxf(v1[e], 0.f); v0[e] = a * a; v1[e] = b * b; } }
                    u32x4 w; w.x = cvt_pk_bf16(v0[0], v0[1]); w.y = cvt_pk_bf16(v0[2], v0[3]); w.z = cvt_pk_bf16(v1[0], v1[1]); w.w = cvt_pk_bf16(v1[2], v1[3]);
                    *(u32x4*)(rowp + (HM ? (size_t)bj * 16384 * 128 : (size_t)bj * HALF)) = w; } }
    }
};
struct EpiRes {
    static constexpr bool PERM = true, AFTER_DRAIN = false;
    const float* base; float* out; const float* gate; int gstride; int ldc;
    __device__ __forceinline__ void operator()(const f32x4 (&acc)[2][2][4][2], const Unit& u, int wr, int wc, int fr, int fq) const {
        const int col0 = u.pn * BM + wc * 32 + 8 * fq; const float* g = gate + (size_t)(u.pm >> 6) * gstride + col0;
        f32x4 gv[2][2];
#pragma unroll
        for (int bj = 0; bj < 2; ++bj)
#pragma unroll
            for (int n = 0; n < 2; ++n) gv[bj][n] = *(const f32x4*)(g + bj * HALF + n * 4);
#pragma unroll
        for (int ai = 0; ai < 2; ++ai)
#pragma unroll
            for (int m = 0; m < 4; ++m) { const size_t off = (size_t)(u.pm * BM + ai * HALF + wr * 64 + m * 16 + fr) * ldc + col0;
#pragma unroll
                for (int bj = 0; bj < 2; ++bj)
#pragma unroll
                    for (int n = 0; n < 2; ++n) { const f32x4 bs = *(const f32x4*)(base + off + bj * HALF + n * 4);
                        *(f32x4*)(out + off + bj * HALF + n * 4) = bs + gv[bj][n] * acc[ai][bj][m][n]; }
                if (m & 1) asm volatile("" ::: "memory"); }
    }
};

__device__ __forceinline__ void pg8_glds_s(const void* sbase, unsigned voff, unsigned ldsaddr) {
    unsigned keep;
    asm volatile("s_mov_b32 %0, m0\n\ts_mov_b32 m0, %3\n\ts_nop 0\n\tglobal_load_lds_dwordx4 %1, %2\n\ts_mov_b32 m0, %0" : "=&s"(keep) : "v"(voff), "s"(sbase), "s"(ldsaddr) : "memory");
}
template <class Epi, class Sched, bool ALIGN_EPI = false, bool SP2 = false>
__device__ __forceinline__ void gemm_phase(PG8_LAS unsigned char* lds, const Gemm g, const Sched& S, const Epi& E, const int tid) {
    const int wid = __builtin_amdgcn_readfirstlane(tid >> 6), lane = tid & 63, wr = wid >> 2, wc = wid & 3, fr = lane & 15, fq = lane >> 4;
    const int K = g.K, nt = K / BK;
    unsigned voffA[2], voffB[2];
#pragma unroll
    for (int i = 0; i < 2; ++i) { int R, C; stage_rc(tid * 16 + i * 8192, R, C); const int Rb = Epi::PERM ? ((R & ~31) + perm32(R & 31)) : R;
        voffA[i] = (unsigned)(R * K + C) * 2u; voffB[i] = (unsigned)(Rb * K + C) * 2u; }
    const size_t kstep = (size_t)(BK * 2);
    const size_t hstep = (size_t)HALF * K * 2;
    const size_t tstep = 2 * hstep;
    const unsigned ldsw = (unsigned)wid * 1024u, ldsb0 = (unsigned)(uintptr_t)lds;
    const int aoff = lds_byte(wr * 64 + fr, fq * 8), boff = lds_byte(wc * 32 + fr, fq * 8);
#define PG8_SA(b, h) (((b) * 2 + (h)) * HTB)
#define PG8_SB(b, h) ((4 + (b) * 2 + (h)) * HTB)
#define PG8_STAGE(bufoff, gbase, voff) do { _Pragma("unroll") for (int _i = 0; _i < 2; ++_i) \
        pg8_glds_s((const void*)(gbase), (voff)[_i], ldsb0 + (unsigned)(bufoff) + ldsw + _i * 8192u); } while (0)
#define PG8_LDA(dst, b, h) do { _Pragma("unroll") for (int m = 0; m < 4; ++m) _Pragma("unroll") for (int k = 0; k < 2; ++k) dst[m][k] = *(const PG8_LAS bf16x8*)(lds + PG8_SA(b, h) + aoff + m * 2048 + k * 1024); } while (0)
#define PG8_LDB(dst, b, h) do { _Pragma("unroll") for (int n = 0; n < 2; ++n) _Pragma("unroll") for (int k = 0; k < 2; ++k) dst[n][k] = *(const PG8_LAS bf16x8*)(lds + PG8_SB(b, h) + boff + n * 2048 + k * 1024); } while (0)
#define PG8_MMA(ai, bj, At, Bt) do { __builtin_amdgcn_s_setprio(1); _Pragma("unroll") for (int m = 0; m < 4; ++m) _Pragma("unroll") for (int n = 0; n < 2; ++n) _Pragma("unroll") for (int k = 0; k < 2; ++k) \
        acc[ai][bj][m][n] = __builtin_amdgcn_mfma_f32_16x16x32_bf16(Bt[n][k], At[m][k], acc[ai][bj][m][n], 0, 0, 0); __builtin_amdgcn_s_setprio(0); } while (0)
#define PG8_WAIT_V(n) asm volatile("s_waitcnt vmcnt(" #n ")" ::: "memory")
#define PG8_WAIT_L(n) asm volatile("s_waitcnt lgkmcnt(" #n ")" ::: "memory")
#define PG8_BAR __builtin_amdgcn_s_barrier()
#define PG8_SCHED __builtin_amdgcn_sched_barrier(0)
    Unit cur, nxt; int ui = 0;
    if (!S.next(0, cur)) return;
    f32x4 acc[2][2][4][2];
#pragma unroll
    for (int a = 0; a < 2; ++a)
#pragma unroll
        for (int b = 0; b < 2; ++b)
#pragma unroll
            for (int m = 0; m < 4; ++m)
#pragma unroll
                for (int n = 0; n < 2; ++n) acc[a][b][m][n] = (f32x4){0.f, 0.f, 0.f, 0.f};
    bf16x8 At[4][2], B0[2][2], B1[2][2];
    const char* cA = (const char*)g.A + (size_t)cur.pm * tstep; const char* cB = (const char*)g.Bt + (size_t)cur.pn * tstep;
    S.a_ready(cur);
    if constexpr (SP2) {
        PG8_STAGE(PG8_SB(0, 0), cB, voffB); PG8_STAGE(PG8_SB(0, 1), cB + hstep, voffB); PG8_STAGE(PG8_SA(0, 0), cA, voffA); PG8_STAGE(PG8_SA(0, 1), cA + hstep, voffA);
        if (wr == 1) PG8_BAR;
        PG8_WAIT_V(2); PG8_BAR;
        PG8_STAGE(PG8_SB(1, 0), cB + kstep, voffB); PG8_STAGE(PG8_SA(1, 0), cA + kstep, voffA); PG8_STAGE(PG8_SB(1, 1), cB + hstep + kstep, voffB);
        PG8_WAIT_V(6); PG8_BAR;
    } else {
        PG8_STAGE(PG8_SB(0, 0), cB, voffB); PG8_STAGE(PG8_SA(0, 0), cA, voffA); PG8_STAGE(PG8_SB(0, 1), cB + hstep, voffB); PG8_STAGE(PG8_SA(0, 1), cA + hstep, voffA);
        if (wr == 1) PG8_BAR;
        PG8_WAIT_V(4); PG8_BAR;
        PG8_STAGE(PG8_SB(1, 0), cB + kstep, voffB); PG8_STAGE(PG8_SA(1, 0), cA + kstep, voffA); PG8_STAGE(PG8_SB(1, 1), cB + hstep + kstep, voffB);
        PG8_WAIT_V(6); PG8_BAR;
    }
    for (;;) {
        const bool has_next = S.next(ui + 1, nxt);
        const char* nA = has_next ? (const char*)g.A + (size_t)nxt.pm * tstep : cA; const char* nB = has_next ? (const char*)g.Bt + (size_t)nxt.pn * tstep : cB;
        for (int t = 0; t < nt; t += 2) {
            const bool last = (t == nt - 2);
            const char* a1 = cA + (size_t)(t + 1) * kstep;
            const char* a2 = last ? nA : cA + (size_t)(t + 2) * kstep; const char* b2 = last ? nB : cB + (size_t)(t + 2) * kstep;
            const char* a3 = a2 + kstep; const char* b3 = b2 + kstep;
            if (last && has_next) S.a_ready(nxt);
            if constexpr (SP2) {
            PG8_LDB(B0, 0, 0); PG8_LDB(B1, 0, 1); PG8_SCHED; PG8_LDA(At, 0, 0); PG8_STAGE(PG8_SA(1, 1), a1 + hstep, voffA);
            PG8_WAIT_V(8); PG8_WAIT_L(0); PG8_BAR; PG8_MMA(0, 0, At, B0); PG8_MMA(0, 1, At, B1); PG8_BAR; PG8_SCHED;
            PG8_LDA(At, 0, 1); PG8_STAGE(PG8_SB(0, 0), b2, voffB); PG8_STAGE(PG8_SB(0, 1), b2 + hstep, voffB); PG8_STAGE(PG8_SA(0, 0), a2, voffA);
            PG8_WAIT_V(8); PG8_WAIT_L(0); PG8_BAR; PG8_MMA(1, 0, At, B0); PG8_MMA(1, 1, At, B1); PG8_BAR; PG8_SCHED;
            PG8_LDB(B0, 1, 0); PG8_LDB(B1, 1, 1); PG8_SCHED; PG8_LDA(At, 1, 0); PG8_STAGE(PG8_SA(0, 1), a2 + hstep, voffA);
            PG8_WAIT_V(8); PG8_WAIT_L(0); PG8_BAR; PG8_MMA(0, 0, At, B0); PG8_MMA(0, 1, At, B1); PG8_BAR; PG8_SCHED;
            PG8_LDA(At, 1, 1); PG8_STAGE(PG8_SB(1, 0), b3, voffB); PG8_STAGE(PG8_SB(1, 1), b3 + hstep, voffB); PG8_STAGE(PG8_SA(1, 0), a3, voffA);
            PG8_WAIT_V(8); PG8_WAIT_L(0); PG8_BAR; PG8_MMA(1, 0, At, B0); PG8_MMA(1, 1, At, B1); PG8_BAR; PG8_SCHED;
            } else {
            PG8_LDB(B0, 0, 0); PG8_SCHED; PG8_LDA(At, 0, 0); PG8_STAGE(PG8_SA(1, 1), a1 + hstep, voffA);
            PG8_WAIT_L(8); PG8_BAR; PG8_WAIT_L(0); PG8_MMA(0, 0, At, B0); PG8_BAR; PG8_SCHED;
            PG8_LDB(B1, 0, 1); PG8_STAGE(PG8_SB(0, 0), b2, voffB);
            PG8_BAR; PG8_WAIT_L(0); PG8_MMA(0, 1, At, B1); PG8_BAR;
            PG8_LDA(At, 0, 1); PG8_STAGE(PG8_SA(0, 0), a2, voffA);
            PG8_BAR; PG8_WAIT_L(0); PG8_MMA(1, 0, At, B0); PG8_BAR; PG8_SCHED;
            PG8_STAGE(PG8_SB(0, 1), b2 + hstep, voffB);
            PG8_WAIT_V(6); PG8_BAR; PG8_MMA(1, 1, At, B1); PG8_BAR;
            PG8_LDB(B0, 1, 0); PG8_SCHED; PG8_LDA(At, 1, 0); PG8_STAGE(PG8_SA(0, 1), a2 + hstep, voffA);
            PG8_WAIT_L(8); PG8_BAR; PG8_WAIT_L(0); PG8_MMA(0, 0, At, B0); PG8_BAR; PG8_SCHED;
            PG8_LDB(B1, 1, 1); PG8_STAGE(PG8_SB(1, 0), b3, voffB);
            PG8_BAR; PG8_WAIT_L(0); PG8_MMA(0, 1, At, B1); PG8_BAR;
            PG8_LDA(At, 1, 1); PG8_STAGE(PG8_SA(1, 0), a3, voffA);
            PG8_BAR; PG8_WAIT_L(0); PG8_MMA(1, 0, At, B0); PG8_BAR; PG8_SCHED;
            PG8_STAGE(PG8_SB(1, 1), b3 + hstep, voffB);
            PG8_WAIT_V(6); PG8_BAR; PG8_MMA(1, 1, At, B1); PG8_BAR;
            }
        }
        if constexpr (ALIGN_EPI) { if (wr == 0) PG8_BAR; }
        if constexpr (!Epi::AFTER_DRAIN) { E(acc, cur, wr, wc, fr, fq); S.done(cur); }
        if (!has_next) break;
#pragma unroll
        for (int a = 0; a < 2; ++a)
#pragma unroll
            for (int b = 0; b < 2; ++b)
#pragma unroll
                for (int m = 0; m < 4; ++m)
#pragma unroll
                    for (int n = 0; n < 2; ++n) acc[a][b][m][n] = (f32x4){0.f, 0.f, 0.f, 0.f};
        cur = nxt; cA = nA; cB = nB; ++ui;
        if constexpr (ALIGN_EPI) { if (wr == 1) PG8_BAR; }
    }
    PG8_WAIT_V(0);
    if constexpr (!ALIGN_EPI) { if (wr == 0) PG8_BAR; }
    PG8_BAR;
#undef PG8_SA
#undef PG8_SB
#undef PG8_STAGE
#undef PG8_LDA
#undef PG8_LDB
#undef PG8_MMA
#undef PG8_WAIT_V
#undef PG8_WAIT_L
#undef PG8_BAR
#undef PG8_SCHED
}
}

typedef unsigned short bf16_t;
constexpr int BATCH = 2, SEQ = 16384, DM = 2048, MTOK = BATCH * SEQ, DEPTH = 2;
constexpr int IN_COLS = 3904, IN_PAD = 4096, DFF = 8192, QL = 512, KVL = 256, NQM = 1536, NKV = 2048, MODW = 6 * DM;
constexpr int OFF_DQ = 0, OFF_DK = 1024, OFF_DV = 2048, OFF_CQ = 3072, OFF_CKV = 3584, OFF_KR = 3840;
constexpr float EPS = 1e-6f, LOG2E = 1.4426950408889634f;

constexpr size_t MiB = 1u << 20;
constexpr size_t WS_CTL = 0;
constexpr size_t CTL_MOD = 0;
constexpr size_t CTL_LUT = 256 * 1024;
constexpr size_t CTL_LAM = CTL_LUT + 8192;
constexpr size_t CTL_PMM = CTL_LAM + 256;
constexpr size_t WS_ROPE = 2 * MiB;
constexpr size_t WS_WIN = 10 * MiB;
constexpr size_t WS_WUQ = 42 * MiB;
constexpr size_t WS_WUKV = 45 * MiB;
constexpr size_t WS_WO = 47 * MiB;
constexpr size_t WS_W1 = 63 * MiB;
constexpr size_t WS_W2 = 127 * MiB;
constexpr size_t WS_CKVN = 191 * MiB;
constexpr size_t WS_KROPE = 207 * MiB;
constexpr size_t WS_HB = 211 * MiB;
constexpr size_t WS_ODIFF = 339 * MiB;
constexpr size_t WS_U = 467 * MiB;
constexpr size_t WS_PROJ = WS_U;
constexpr size_t WS_QM = WS_U + 256 * MiB;
constexpr size_t WS_KV = WS_U + 352 * MiB;
constexpr size_t WS_CQN = WS_U + 480 * MiB;
constexpr size_t WS_END = WS_U + 512 * MiB;

#define LAS __attribute__((address_space(3)))
typedef float f32x4 __attribute__((ext_vector_type(4)));
typedef float f32x2 __attribute__((ext_vector_type(2)));
typedef unsigned u32x4 __attribute__((ext_vector_type(4)));
typedef unsigned u32x2 __attribute__((ext_vector_type(2)));
typedef int i32x4 __attribute__((ext_vector_type(4)));
__device__ __forceinline__ unsigned f2bf(float f) { unsigned u = __builtin_bit_cast(unsigned, f); return (u + 0x7fffu + ((u >> 16) & 1u)) >> 16; }
__device__ __forceinline__ unsigned pk2(float lo, float hi) { return f2bf(lo) | (f2bf(hi) << 16); }
__device__ __forceinline__ float bf_lo(unsigned w) { return __builtin_bit_cast(float, w << 16); }
__device__ __forceinline__ float bf_hi(unsigned w) { return __builtin_bit_cast(float, w & 0xffff0000u); }
__device__ __forceinline__ float shfl_xor_l(float v, int o, int lane) { return __builtin_bit_cast(float, __builtin_amdgcn_ds_bpermute((lane ^ o) << 2, __builtin_bit_cast(int, v))); }
__device__ __forceinline__ float wave_sum(float v, int lane) {
#pragma unroll
    for (int o = 1; o < 64; o <<= 1) v += shfl_xor_l(v, o, lane);
    return v;
}
__device__ const float INV_FREQ[32] = {1.000000000e+00f, 7.498942018e-01f, 5.623413324e-01f, 4.216965139e-01f, 3.162277639e-01f, 2.371373922e-01f, 1.778279394e-01f, 1.333521456e-01f,
    1.000000015e-01f, 7.498941571e-02f, 5.623412877e-02f, 4.216964915e-02f, 3.162277862e-02f, 2.371373586e-02f, 1.778279431e-02f, 1.333521493e-02f,
    9.999999776e-03f, 7.498942316e-03f, 5.623413250e-03f, 4.216964822e-03f, 3.162277862e-03f, 2.371373819e-03f, 1.778279431e-03f, 1.333521446e-03f,
    1.000000047e-03f, 7.498941850e-04f, 5.623413017e-04f, 4.216965463e-04f, 3.162277862e-04f, 2.371373848e-04f, 1.778279402e-04f, 1.333521504e-04f};

namespace att {
using bf16x8 = __attribute__((ext_vector_type(8))) short;
using s16x4 = __attribute__((ext_vector_type(4))) short;
using f32x16 = __attribute__((ext_vector_type(16))) float;
constexpr int NW = 8, QBLK = 32, KVBLK = 64;
constexpr int KP = 272, K2P = 144;
constexpr int SHM_V = 16384, SHM_K = 64 * KP, SHM_K2 = 64 * K2P;
constexpr int OFF_V = 0, OFF_K = 2 * SHM_V, OFF_K2 = OFF_K + 2 * SHM_K, OFF_WS = OFF_K2 + 2 * SHM_K2, OFF_LUT = OFF_WS + NW * 256, OFF_QR = OFF_LUT + 2048, QRB = 32 * KP, ATT_LDS = OFF_QR + NW * QRB;
constexpr float THR2 = 8.f * 1.4426950408889634f;
#define SBAR() __builtin_amdgcn_sched_barrier(0)
__device__ __forceinline__ int crow(int r, int hi) { return (r & 3) + 8 * (r >> 2) + 4 * hi; }
__device__ __forceinline__ unsigned cvtpk(float lo, float hi) { unsigned r; asm volatile("v_cvt_pk_bf16_f32 %0, %1, %2" : "=v"(r) : "v"(lo), "v"(hi)); return r; }
__device__ __forceinline__ int kswz(int row, int colB) { return row * KP + colB; }
__device__ __forceinline__ int k2swz(int row, int colB) { return row * K2P + colB; }
__device__ __forceinline__ int v_st(int k, int c) { const int kk = (k & ~0xC) | ((k & 4) << 1) | ((k & 8) >> 1); return ((kk >> 3) * 4 + (c >> 5)) * 512 + ((kk & 7) * 32 + (c & 31)) * 2; }
__device__ __forceinline__ int v_rd_base(int lane) { return ((lane & 3) << 3) | (((lane >> 2) & 3) << 6) | (((lane >> 4) & 1) << 5) | (((lane >> 5) & 1) << 8); }
constexpr int v_rd_off(int d0, int ks, int half) { return d0 * 512 + ks * 4096 + half * 2048; }
template <int OFF> __device__ __forceinline__ s16x4 tr_read(int vb) { s16x4 r; asm volatile("ds_read_b64_tr_b16 %0, %1 offset:%2" : "=&v"(r) : "v"(vb), "i"(OFF) : "memory"); return r; }
template <int D0> __device__ __forceinline__ void pv_one(f32x16& od, int vb, bf16x8 pa0, bf16x8 pa1, bf16x8 pa2, bf16x8 pa3) {
    const s16x4 l0 = tr_read<v_rd_off(D0, 0, 0)>(vb), h0 = tr_read<v_rd_off(D0, 0, 1)>(vb), l1 = tr_read<v_rd_off(D0, 1, 0)>(vb), h1 = tr_read<v_rd_off(D0, 1, 1)>(vb);
    const s16x4 l2 = tr_read<v_rd_off(D0, 2, 0)>(vb), h2 = tr_read<v_rd_off(D0, 2, 1)>(vb), l3 = tr_read<v_rd_off(D0, 3, 0)>(vb), h3 = tr_read<v_rd_off(D0, 3, 1)>(vb);
    asm volatile("s_waitcnt lgkmcnt(0)" ::: "memory"); SBAR();
#define PK(L, H) (bf16x8){L[0], L[1], L[2], L[3], H[0], H[1], H[2], H[3]}
    od = __builtin_amdgcn_mfma_f32_32x32x16_bf16(pa0, PK(l0, h0), od, 0, 0, 0);
    od = __builtin_amdgcn_mfma_f32_32x32x16_bf16(pa1, PK(l1, h1), od, 0, 0, 0);
    od = __builtin_amdgcn_mfma_f32_32x32x16_bf16(pa2, PK(l2, h2), od, 0, 0, 0);
    od = __builtin_amdgcn_mfma_f32_32x32x16_bf16(pa3, PK(l3, h3), od, 0, 0, 0);
#undef PK
}
__device__ __forceinline__ void pv_d0(f32x16* o, int vb, bf16x8 pa0, bf16x8 pa1, bf16x8 pa2, bf16x8 pa3) {
    pv_one<0>(o[0], vb, pa0, pa1, pa2, pa3); pv_one<1>(o[1], vb, pa0, pa1, pa2, pa3); pv_one<2>(o[2], vb, pa0, pa1, pa2, pa3); pv_one<3>(o[3], vb, pa0, pa1, pa2, pa3);
}
template <int DQK, bool QL> __device__ __forceinline__ void qkt_r(f32x16& p0, f32x16& p1, const char* Ks, const char* K2s, const bf16x8* qr, const char* qrl, int r32, int hi) {
    p0 = f32x16{}; p1 = f32x16{};
#pragma unroll
    for (int d0 = 0; d0 < 8; ++d0) { const int cb = (d0 * 16 + hi * 8) * 2;
        const bf16x8 b0 = *reinterpret_cast<const bf16x8*>(Ks + kswz(r32, cb));
        const bf16x8 b1 = *reinterpret_cast<const bf16x8*>(Ks + kswz(32 + r32, cb));
        bf16x8 qv;
        if (QL && d0 >= 4) qv = *reinterpret_cast<const bf16x8*>(qrl + k2swz(r32, ((d0 - 4) * 16 + hi * 8) * 2)); else qv = qr[d0];
        p0 = __builtin_amdgcn_mfma_f32_32x32x16_bf16(b0, qv, p0, 0, 0, 0);
        p1 = __builtin_amdgcn_mfma_f32_32x32x16_bf16(b1, qv, p1, 0, 0, 0); }
    if constexpr (DQK == 192) {
#pragma unroll
        for (int d0 = 0; d0 < 4; ++d0) { const int cb = (d0 * 16 + hi * 8) * 2;
            const bf16x8 b0 = *reinterpret_cast<const bf16x8*>(K2s + k2swz(r32, cb));
            const bf16x8 b1 = *reinterpret_cast<const bf16x8*>(K2s + k2swz(32 + r32, cb));
            p0 = __builtin_amdgcn_mfma_f32_32x32x16_bf16(b0, qr[8 + d0], p0, 0, 0, 0);
            p1 = __builtin_amdgcn_mfma_f32_32x32x16_bf16(b1, qr[8 + d0], p1, 0, 0, 0); }
    }
}
template <int DQK> __device__ __forceinline__ void qkt(f32x16& p0, f32x16& p1, const char* Ks, const char* K2s, const bf16x8* qr, const char* qrl, int r32, int hi) {
    p0 = f32x16{}; p1 = f32x16{};
#pragma unroll
    for (int d0 = 0; d0 < 8; ++d0) { const int cb = (d0 * 16 + hi * 8) * 2;
        const bf16x8 b0 = *reinterpret_cast<const bf16x8*>(Ks + kswz(r32, cb));
        const bf16x8 b1 = *reinterpret_cast<const bf16x8*>(Ks + kswz(32 + r32, cb));
        bf16x8 qv;
        if (DQK == 192 && d0 >= 4) qv = *reinterpret_cast<const bf16x8*>(qrl + kswz(r32, 128 + ((d0 - 4) * 16 + hi * 8) * 2)); else qv = qr[d0];
        p0 = __builtin_amdgcn_mfma_f32_32x32x16_bf16(b0, qv, p0, 0, 0, 0);
        p1 = __builtin_amdgcn_mfma_f32_32x32x16_bf16(b1, qv, p1, 0, 0, 0); }
    if constexpr (DQK == 192) {
#pragma unroll
        for (int d0 = 0; d0 < 4; ++d0) { const int cb = (d0 * 16 + hi * 8) * 2;
            const bf16x8 b0 = *reinterpret_cast<const bf16x8*>(K2s + k2swz(r32, cb));
            const bf16x8 b1 = *reinterpret_cast<const bf16x8*>(K2s + k2swz(32 + r32, cb));
            const bf16x8 qv = *reinterpret_cast<const bf16x8*>(qrl + kswz(r32, cb));
            p0 = __builtin_amdgcn_mfma_f32_32x32x16_bf16(b0, qv, p0, 0, 0, 0);
            p1 = __builtin_amdgcn_mfma_f32_32x32x16_bf16(b1, qv, p1, 0, 0, 0); }
    }
}
template <bool BIAS, bool DEFER = false> __device__ __forceinline__ void partialSM(f32x16& p0, f32x16& p1, float& m_reg, float& alpha, float C, float tb2, bool slow,
                                                                const int* __restrict__ posk, int pq, const float* lut, int hi, float* cm_out = nullptr, float* off_out = nullptr, bool chk = true) {
    float cm = C, tb = BIAS ? tb2 : 0.f;
    if constexpr (BIAS) {
        if (slow) {
#pragma unroll
            for (int g = 0; g < 4; ++g) { const i32x4 ka = *(const i32x4*)(posk + 8 * g + 4 * hi), kb = *(const i32x4*)(posk + 32 + 8 * g + 4 * hi);
#pragma unroll
                for (int e = 0; e < 4; ++e) { int ia = ka[e] - pq; ia = ia < -128 ? -128 : (ia > 128 ? 128 : ia); int ib = kb[e] - pq; ib = ib < -128 ? -128 : (ib > 128 ? 128 : ib);
                    p0[4 * g + e] = fmaf(p0[4 * g + e], C, lut[ia + 128]); p1[4 * g + e] = fmaf(p1[4 * g + e], C, lut[ib + 128]); }
                asm volatile("" ::: "memory"); }
            cm = 1.f; tb = 0.f;
        }
    }
    float mn = m_reg; alpha = 1.f;
    if (chk) {
        float pmax = p0[0];
#pragma unroll
        for (int r = 1; r < 16; ++r) pmax = fmaxf(pmax, p0[r]);
#pragma unroll
        for (int r = 0; r < 16; ++r) pmax = fmaxf(pmax, p1[r]);
        { auto rr = __builtin_amdgcn_permlane32_swap(__float_as_uint(pmax), __float_as_uint(pmax), false, false);
          pmax = fmaxf(__uint_as_float(rr[0]), __uint_as_float(rr[1])); }
        const float tmax = fmaf(pmax, cm, tb);
        if (__builtin_expect(!__all(tmax - m_reg <= THR2), 0)) { mn = fmaxf(m_reg, tmax); alpha = __builtin_amdgcn_exp2f(m_reg - mn); m_reg = mn; }
    }
    const float off = tb - mn;
#pragma unroll
    for (int r = 0; r < 16; ++r) p0[r] = fmaf(p0[r], cm, off);
    if constexpr (DEFER) { *cm_out = cm; *off_out = off; }
    else {
#pragma unroll
        for (int r = 0; r < 16; ++r) p1[r] = fmaf(p1[r], cm, off); }
#pragma unroll
    for (int r = 0; r < 16; ++r) p0[r] = __builtin_amdgcn_exp2f(p0[r]);
}
template <bool BIAS> __device__ __forceinline__ void smFront(f32x16& p0, f32x16& p1, float& m_reg, float& alpha, bool slow, bool first,
                                                              const int* __restrict__ posk, int pq, const float* lut, int hi, bool chk = true) {
    if constexpr (BIAS) {
        if (slow) {
#pragma unroll
            for (int g = 0; g < 4; ++g) { const i32x4 ka = *(const i32x4*)(posk + 8 * g + 4 * hi), kb = *(const i32x4*)(posk + 32 + 8 * g + 4 * hi);
#pragma unroll
                for (int e = 0; e < 4; ++e) { int ia = ka[e] - pq; ia = ia < -128 ? -128 : (ia > 128 ? 128 : ia); int ib = kb[e] - pq; ib = ib < -128 ? -128 : (ib > 128 ? 128 : ib);
                    p0[4 * g + e] += lut[ia + 128]; p1[4 * g + e] += lut[ib + 128]; } }
        }
    }
    alpha = 1.f;
    if (chk) {
    float pmax = p0[0];
#pragma unroll
    for (int r = 1; r < 16; ++r) pmax = fmaxf(pmax, p0[r]);
#pragma unroll
    for (int r = 0; r < 16; ++r) pmax = fmaxf(pmax, p1[r]);
    { auto rr = __builtin_amdgcn_permlane32_swap(__float_as_uint(pmax), __float_as_uint(pmax), false, false);
      pmax = fmaxf(__uint_as_float(rr[0]), __uint_as_float(rr[1])); }
    if (__builtin_expect(first || !__all(pmax <= THR2), 0)) {
        const float d = first ? pmax : fmaxf(pmax, 0.f);
        if (!first) alpha = __builtin_amdgcn_exp2f(-d);
        m_reg += d;
#pragma unroll
        for (int r = 0; r < 16; ++r) { p0[r] -= d; p1[r] -= d; }
    }
    }
#pragma unroll
    for (int r = 0; r < 16; ++r) p0[r] = __builtin_amdgcn_exp2f(p0[r]);
}
template <int BASE> __device__ __forceinline__ bf16x8 pk8r(const f32x16& P) {
    u32x4 w = {cvtpk(P[BASE + 0], P[BASE + 1]), cvtpk(P[BASE + 2], P[BASE + 3]), cvtpk(P[BASE + 4], P[BASE + 5]), cvtpk(P[BASE + 6], P[BASE + 7])}; return *reinterpret_cast<bf16x8*>(&w);
}
template <int BASE> __device__ __forceinline__ bf16x8 pk8(const f32x16& P) {
    const unsigned a0 = cvtpk(P[BASE + 0], P[BASE + 1]), a1 = cvtpk(P[BASE + 2], P[BASE + 3]), b0 = cvtpk(P[BASE + 4], P[BASE + 5]), b1 = cvtpk(P[BASE + 6], P[BASE + 7]);
    auto r0 = __builtin_amdgcn_permlane32_swap(a0, b0, false, false); auto r1 = __builtin_amdgcn_permlane32_swap(a1, b1, false, false);
    u32x4 w = {r0[0], r1[0], r0[1], r1[1]}; return *reinterpret_cast<bf16x8*>(&w);
}
__device__ __forceinline__ void finishSM(f32x16& p0, f32x16& p1, float alpha, float& l_reg, bf16x8& pa0, bf16x8& pa1, bf16x8& pa2, bf16x8& pa3) {
#pragma unroll
    for (int r = 0; r < 16; ++r) p1[r] = __builtin_amdgcn_exp2f(p1[r]);
    float ps = 0;
#pragma unroll
    for (int r = 0; r < 16; ++r) ps += p0[r];
#pragma unroll
    for (int r = 0; r < 16; ++r) ps += p1[r];
    { auto rr = __builtin_amdgcn_permlane32_swap(__float_as_uint(ps), __float_as_uint(ps), false, false);
      ps = __uint_as_float(rr[0]) + __uint_as_float(rr[1]); }
    l_reg = l_reg * alpha + ps;
#define PK4(P, BASE, OUT) do { unsigned a0 = cvtpk(P[BASE + 0], P[BASE + 1]), a1 = cvtpk(P[BASE + 2], P[BASE + 3]);   \
    unsigned b0 = cvtpk(P[BASE + 4], P[BASE + 5]), b1 = cvtpk(P[BASE + 6], P[BASE + 7]);                              \
    auto r0 = __builtin_amdgcn_permlane32_swap(a0, b0, false, false); auto r1 = __builtin_amdgcn_permlane32_swap(a1, b1, false, false); \
    u32x4 w = {r0[0], r1[0], r0[1], r1[1]}; OUT = *reinterpret_cast<bf16x8*>(&w); } while (0)
    PK4(p0, 0, pa0); PK4(p0, 8, pa1); PK4(p1, 0, pa2); PK4(p1, 8, pa3);
#undef PK4
}

template <int DQK, bool BIAS>
__device__ __forceinline__ void attn_unit(const bf16_t* __restrict__ Qb, int ldq, const bf16_t* __restrict__ K1, int ldk1, const bf16_t* __restrict__ K2,
                                          const bf16_t* __restrict__ Vh, int ldv, bf16_t* __restrict__ Ob, int ldo, const float* __restrict__ ropeq,
                                          const int* __restrict__ posb, const int* __restrict__ pmmb, int q0, const float* __restrict__ lutg, float C, int seq, char* lds, const int tid) {
    const int wid = tid >> 6, lane = tid & 63, r32 = lane & 31, hi = lane >> 5;
    char* V_lds = lds + OFF_V; char* K_lds = lds + OFF_K; char* K2_lds = lds + OFF_K2;
    float* ws = (float*)(lds + OFF_WS) + wid * 64; float* li_l = ws; float* al_l = ws + 32; float* lut = (float*)(lds + OFF_LUT);
    float m_reg = -1e30f, l_reg = 0; f32x16 o[4] = {}; bf16x8 qr[8]; char* qrl = lds + OFF_QR + wid * QRB;
    const bf16_t* Qw = Qb + (long)(wid * QBLK + r32) * ldq + hi * 8;
#pragma unroll
    for (int d0 = 0; d0 < (DQK == 192 ? 4 : 8); ++d0) qr[d0] = *reinterpret_cast<const bf16x8*>(Qw + d0 * 16);
    if constexpr (DQK == 192) {
#pragma unroll
        for (int d0 = 4; d0 < 8; ++d0) *reinterpret_cast<bf16x8*>(qrl + kswz(r32, 128 + ((d0 - 4) * 16 + hi * 8) * 2)) = *reinterpret_cast<const bf16x8*>(Qw + d0 * 16);
        const float* rp = ropeq + (long)(wid * QBLK + r32) * 64;
#pragma unroll
        for (int pr = 0; pr < 2; ++pr) {
            const u32x4 x1 = *reinterpret_cast<const u32x4*>(Qw + (8 + pr) * 16), x2 = *reinterpret_cast<const u32x4*>(Qw + (10 + pr) * 16); u32x4 y1, y2;
#pragma unroll
            for (int w = 0; w < 4; ++w) { const f32x4 cs = *(const f32x4*)(rp + (pr * 16 + hi * 8 + 2 * w) * 2);
                const float a0 = bf_lo(x1[w]), a1 = bf_hi(x1[w]), b0 = bf_lo(x2[w]), b1 = bf_hi(x2[w]);
                y1[w] = cvtpk(a0 * cs[0] - b0 * cs[1], a1 * cs[2] - b1 * cs[3]); y2[w] = cvtpk(b0 * cs[0] + a0 * cs[1], b1 * cs[2] + a1 * cs[3]); }
            *reinterpret_cast<u32x4*>(qrl + kswz(r32, (pr * 16 + hi * 8) * 2)) = y1; *reinterpret_cast<u32x4*>(qrl + kswz(r32, ((2 + pr) * 16 + hi * 8) * 2)) = y2;
        }
    }
    unsigned cls_pack = 0; int pq = 0; float bneg2 = 0.f, bpos2 = 0.f;
    if constexpr (BIAS) {
        const int qg = (q0 >> 5) + wid; const int qmin = pmmb[2 * qg], qmax = pmmb[2 * qg + 1];
#pragma unroll
        for (int t4 = 0; t4 < 4; ++t4) { const int tl = lane * 4 + t4;
            const i32x4 mm = *(const i32x4*)(pmmb + 4 * tl); const int kmin = min(mm[0], mm[2]), kmax = max(mm[1], mm[3]);
            const unsigned c = (kmin - qmax >= 91) ? 1u : ((qmin - kmax >= 91) ? 0u : 2u); cls_pack |= c << (2 * t4); }
        pq = posb[q0 + wid * QBLK + r32];
        for (int i = tid; i < 257; i += 512) lut[i] = lutg[i];
        bneg2 = lutg[0]; bpos2 = lutg[256];
    }
    const int sr = tid >> 4, sc = (tid & 15) * 8, vst0 = v_st(sr, sc), vst1 = v_st(32 + sr, sc);
    const int s2r = tid >> 3, s2c = (tid & 7) * 8;
    const int vb0 = (int)(uintptr_t)V_lds + v_rd_base(lane);
    bf16x8 vs0, vs1, ks0, ks1, k2s;
    const unsigned vo0 = (unsigned)(sr * ldv + sc) * 2u, vo1 = vo0 + (unsigned)(32 * ldv) * 2u, ko0 = (unsigned)(sr * ldk1 + sc) * 2u, ko1 = ko0 + (unsigned)(32 * ldk1) * 2u, k2o = (unsigned)(s2r * 64 + s2c) * 2u;
#define SLOAD(k0) do { const char* vt_ = (const char*)Vh + (size_t)(k0) * ldv * 2; const char* kt_ = (const char*)K1 + (size_t)(k0) * ldk1 * 2; \
    vs0 = *reinterpret_cast<const bf16x8*>(vt_ + vo0); vs1 = *reinterpret_cast<const bf16x8*>(vt_ + vo1); \
    ks0 = *reinterpret_cast<const bf16x8*>(kt_ + ko0); ks1 = *reinterpret_cast<const bf16x8*>(kt_ + ko1); \
    if constexpr (DQK == 192) k2s = *reinterpret_cast<const bf16x8*>((const char*)K2 + (size_t)(k0) * 128 + k2o); } while (0)
#define SWRITE(b) do { *(bf16x8*)(V_lds + (b) * SHM_V + vst0) = vs0; *(bf16x8*)(V_lds + (b) * SHM_V + vst1) = vs1; \
    *(bf16x8*)(K_lds + (b) * SHM_K + kswz(sr, sc * 2)) = ks0; *(bf16x8*)(K_lds + (b) * SHM_K + kswz(32 + sr, sc * 2)) = ks1; \
    if constexpr (DQK == 192) *(bf16x8*)(K2_lds + (b) * SHM_K2 + k2swz(s2r, s2c * 2)) = k2s; } while (0)
#define RESC(a) do { if (__any((a) < 1.f)) { if (hi == 0) al_l[r32] = (a); asm volatile("s_waitcnt lgkmcnt(0)" ::: "memory"); \
    _Pragma("unroll") for (int d = 0; d < 4; ++d) _Pragma("unroll") for (int r = 0; r < 16; ++r) o[d][r] *= al_l[crow(r, hi)]; } } while (0)
#define TCLS(t, TB, SL) do { if constexpr (BIAS) { const unsigned cw_ = (unsigned)__builtin_amdgcn_readlane((int)cls_pack, (t) >> 2); const unsigned c_ = (cw_ >> (2 * ((t) & 3))) & 3u; \
    SL = (c_ == 2u); TB = (c_ == 1u) ? bpos2 : bneg2; } else { SL = false; TB = 0.f; } } while (0)
    f32x16 pA0, pA1, pB0, pB1; float alA, alB; bf16x8 pa0, pa1, pa2, pa3; const int NT = seq / KVBLK;
    float tbx; bool slx;
    SLOAD(0); asm volatile("s_waitcnt vmcnt(0)" ::: "memory"); SWRITE(0); __syncthreads();
    qkt<DQK>(pA0, pA1, K_lds, K2_lds, qr, qrl, r32, hi); TCLS(0, tbx, slx); partialSM<BIAS>(pA0, pA1, m_reg, alA, C, tbx, slx, posb, pq, lut, hi);
    SLOAD(KVBLK);
    asm volatile("s_waitcnt vmcnt(0)" ::: "memory"); SWRITE(1); __syncthreads();
    for (int j = 1; j + 1 < NT; j += 2) {
        SBAR(); qkt<DQK>(pB0, pB1, K_lds + SHM_K, K2_lds + SHM_K2, qr, qrl, r32, hi);
        finishSM(pA0, pA1, alA, l_reg, pa0, pa1, pa2, pa3); SBAR();
        SLOAD((j + 1) * KVBLK); SBAR();
        pv_d0(o, vb0, pa0, pa1, pa2, pa3); TCLS(j, tbx, slx); partialSM<BIAS>(pB0, pB1, m_reg, alB, C, tbx, slx, posb + j * KVBLK, pq, lut, hi);
        __syncthreads(); SWRITE(0);
        RESC(alB); __syncthreads();
        SBAR(); qkt<DQK>(pA0, pA1, K_lds, K2_lds, qr, qrl, r32, hi);
        finishSM(pB0, pB1, alB, l_reg, pa0, pa1, pa2, pa3); SBAR();
        SLOAD((j + 2 < NT ? j + 2 : j + 1) * KVBLK); SBAR();
        pv_d0(o, vb0 + SHM_V, pa0, pa1, pa2, pa3); TCLS(j + 1, tbx, slx); partialSM<BIAS>(pA0, pA1, m_reg, alA, C, tbx, slx, posb + (j + 1) * KVBLK, pq, lut, hi);
        __syncthreads(); SWRITE(1);
        RESC(alA); __syncthreads();
    }
    SBAR(); qkt<DQK>(pB0, pB1, K_lds + SHM_K, K2_lds + SHM_K2, qr, qrl, r32, hi);
    finishSM(pA0, pA1, alA, l_reg, pa0, pa1, pa2, pa3); SBAR();
    pv_d0(o, vb0, pa0, pa1, pa2, pa3); TCLS(NT - 1, tbx, slx); partialSM<BIAS>(pB0, pB1, m_reg, alB, C, tbx, slx, posb + (NT - 1) * KVBLK, pq, lut, hi);
    __syncthreads(); RESC(alB);
    finishSM(pB0, pB1, alB, l_reg, pa0, pa1, pa2, pa3); SBAR();
    pv_d0(o, vb0 + SHM_V, pa0, pa1, pa2, pa3);
    if (hi == 0) li_l[r32] = l_reg; asm volatile("s_waitcnt lgkmcnt(0)" ::: "memory");
    float rli[16];
#pragma unroll
    for (int r = 0; r < 16; ++r) rli[r] = __builtin_amdgcn_rcpf(li_l[crow(r, hi)]);
    __syncthreads();
    bf16_t* stg = (bf16_t*)(lds + wid * 8192);
#pragma unroll
    for (int r = 0; r < 16; ++r) { const int orow = crow(r, hi);
#pragma unroll
        for (int d0 = 0; d0 < 4; ++d0) stg[orow * 128 + d0 * 32 + r32] = (bf16_t)f2bf(o[d0][r] * rli[r]); }
    asm volatile("s_waitcnt lgkmcnt(0)" ::: "memory");
    bf16_t* Ow = Ob + (long)(wid * QBLK) * ldo;
#pragma unroll
    for (int i = 0; i < 8; ++i) { const int row = i * 4 + (lane >> 4), ch = lane & 15; const u32x4 v = *(const u32x4*)(stg + row * 128 + ch * 8); *(u32x4*)(Ow + (long)row * ldo + ch * 8) = v; }
    __syncthreads();
#undef SLOAD
#undef SWRITE
#undef RESC
#undef TCLS
}

template <int OFF> __device__ __forceinline__ bf16x8 rd128(int a) { bf16x8 r; asm volatile("ds_read_b128 %0, %1 offset:%2" : "=&v"(r) : "v"(a), "i"(OFF) : "memory"); return r; }
template <int N> __device__ __forceinline__ void waitl() { asm volatile("s_waitcnt lgkmcnt(%0)" :: "i"(N) : "memory"); }
template <int DQK, bool QL, int I> __device__ __forceinline__ void qk_rd(bf16x8& fa, bf16x8& fb, bf16x8& fq, int kb, int k2b, int qlb) {
    if constexpr (I < 8) { fa = rd128<I * 32>(kb); fb = rd128<32 * KP + I * 32>(kb); if constexpr (QL && I >= 4) fq = rd128<(I - 4) * 32>(qlb); }
    else { fa = rd128<(I - 8) * 32>(k2b); fb = rd128<32 * K2P + (I - 8) * 32>(k2b); }
}
template <int DQK, bool QL, int I> __device__ __forceinline__ void qk_steps(f32x16& p0, f32x16& p1, int kb, int k2b, int qlb, const bf16x8* qr,
                                                                            bf16x8& fa0, bf16x8& fb0, bf16x8& fq0, bf16x8& fa1, bf16x8& fb1, bf16x8& fq1) {
    constexpr int NI = DQK / 16;
    if constexpr (I + 1 < NI) qk_rd<DQK, QL, I + 1>(fa1, fb1, fq1, kb, k2b, qlb);
    waitl<(I + 1 < NI) ? ((QL && I + 1 >= 4 && I + 1 < 8) ? 3 : 2) : 0>(); SBAR();
    bf16x8 q; if constexpr (QL && I >= 4 && I < 8) q = fq0; else q = qr[I];
    p0 = __builtin_amdgcn_mfma_f32_32x32x16_bf16(fa0, q, p0, 0, 0, 0);
    p1 = __builtin_amdgcn_mfma_f32_32x32x16_bf16(fb0, q, p1, 0, 0, 0);
    SBAR();
    if constexpr (I + 1 < NI) qk_steps<DQK, QL, I + 1>(p0, p1, kb, k2b, qlb, qr, fa1, fb1, fq1, fa0, fb0, fq0);
}
template <int DQK, bool QL> __device__ __forceinline__ void qkt_pipe(f32x16& p0, f32x16& p1, int kb, int k2b, int qlb, const bf16x8* qr) {
    p0 = f32x16{}; p1 = f32x16{};
    bf16x8 fa0, fb0, fq0, fa1, fb1, fq1;
    SBAR(); qk_rd<DQK, QL, 0>(fa0, fb0, fq0, kb, k2b, qlb);
    qk_steps<DQK, QL, 0>(p0, p1, kb, k2b, qlb, qr, fa0, fb0, fq0, fa1, fb1, fq1);
}
template <int BLK> __device__ __forceinline__ void pv_rd(s16x4 (&L)[4], s16x4 (&H)[4], int vb) {
    constexpr int base = (BLK >> 2) * 16384, D0 = BLK & 3;
    L[0] = tr_read<base + v_rd_off(D0, 0, 0)>(vb); H[0] = tr_read<base + v_rd_off(D0, 0, 1)>(vb); L[1] = tr_read<base + v_rd_off(D0, 1, 0)>(vb); H[1] = tr_read<base + v_rd_off(D0, 1, 1)>(vb);
    L[2] = tr_read<base + v_rd_off(D0, 2, 0)>(vb); H[2] = tr_read<base + v_rd_off(D0, 2, 1)>(vb); L[3] = tr_read<base + v_rd_off(D0, 3, 0)>(vb); H[3] = tr_read<base + v_rd_off(D0, 3, 1)>(vb);
}
template <int BLK, int KS0> __device__ __forceinline__ void pv_rd2(s16x4 (&L)[2], s16x4 (&H)[2], int vb) {
    constexpr int base = (BLK >> 2) * 16384, D0 = BLK & 3;
    L[0] = tr_read<base + v_rd_off(D0, KS0, 0)>(vb); H[0] = tr_read<base + v_rd_off(D0, KS0, 1)>(vb); L[1] = tr_read<base + v_rd_off(D0, KS0 + 1, 0)>(vb); H[1] = tr_read<base + v_rd_off(D0, KS0 + 1, 1)>(vb);
}
template <int BLK, int NB> __device__ __forceinline__ void pv_steps(f32x16* o, int vb, bf16x8 pa0, bf16x8 pa1, bf16x8 pa2, bf16x8 pa3,
                                                                    s16x4 (&La)[4], s16x4 (&Ha)[4], s16x4 (&Lb)[4], s16x4 (&Hb)[4]) {
    if constexpr (BLK + 1 < NB) pv_rd<BLK + 1>(Lb, Hb, vb);
    waitl<(BLK + 1 < NB) ? 8 : 0>(); SBAR();
#define PK(L, H) (bf16x8){L[0], L[1], L[2], L[3], H[0], H[1], H[2], H[3]}
    o[BLK] = __builtin_amdgcn_mfma_f32_32x32x16_bf16(pa0, PK(La[0], Ha[0]), o[BLK], 0, 0, 0);
    o[BLK] = __builtin_amdgcn_mfma_f32_32x32x16_bf16(pa1, PK(La[1], Ha[1]), o[BLK], 0, 0, 0);
    o[BLK] = __builtin_amdgcn_mfma_f32_32x32x16_bf16(pa2, PK(La[2], Ha[2]), o[BLK], 0, 0, 0);
    o[BLK] = __builtin_amdgcn_mfma_f32_32x32x16_bf16(pa3, PK(La[3], Ha[3]), o[BLK], 0, 0, 0);
#undef PK
    SBAR();
    if constexpr (BLK + 1 < NB) pv_steps<BLK + 1, NB>(o, vb, pa0, pa1, pa2, pa3, Lb, Hb, La, Ha);
}
template <int NB> __device__ __forceinline__ void pv_pipe(f32x16* o, int vb, bf16x8 pa0, bf16x8 pa1, bf16x8 pa2, bf16x8 pa3) {
    s16x4 La[4], Ha[4], Lb[4], Hb[4];
    SBAR(); pv_rd<0>(La, Ha, vb);
    pv_steps<0, NB>(o, vb, pa0, pa1, pa2, pa3, La, Ha, Lb, Hb);
}
constexpr int PP_OFF_WS = 155648, PP_OFF_LUT = 157696;
template <int DQK, int DV, bool BIAS, bool QL>
__device__ __forceinline__ void attn_unit_pp(const bf16_t* __restrict__ Qb, int ldq, const bf16_t* __restrict__ K1, int ldk1, const bf16_t* __restrict__ K2,
                                             const bf16_t* __restrict__ Vh, int ldv, bf16_t* __restrict__ Ob, int ldo, const float* __restrict__ ropeq,
                                             const int* __restrict__ posb, const int* __restrict__ pmmb, int q0, const float* __restrict__ lutg, float C, int seq, char* lds, const int tid) {
    constexpr int NVH = DV / 128, SHM_VX = 16384 * NVH; constexpr bool EARLY = (DV == 128);
    constexpr int P_OFF_V = 0, P_OFF_K = 2 * SHM_VX, P_OFF_K2 = P_OFF_K + 2 * SHM_K, P_OFF_Q = P_OFF_K2 + (DQK == 192 ? 2 * SHM_K2 : 0), QLB = 32 * K2P;
    static_assert(P_OFF_Q + (QL ? NW * QLB : 0) <= PP_OFF_WS && NW * 32 * DV * 2 <= PP_OFF_WS && !(QL && DQK == 192), "pp LDS map");
    const int wid = tid >> 6, lane = tid & 63, r32 = lane & 31, hi = lane >> 5; const int half = __builtin_amdgcn_readfirstlane(wid >> 2);
    char* V_lds = lds + P_OFF_V; char* K_lds = lds + P_OFF_K; char* K2_lds = lds + P_OFF_K2;
    float* ws = (float*)(lds + PP_OFF_WS) + wid * 64; float* li_l = ws; float* al_l = ws + 32; float* lut = (float*)(lds + PP_OFF_LUT);
    float m_reg = -1e30f, l_reg = 0; f32x16 o[4 * NVH] = {}; bf16x8 qr[DQK / 16]; char* qrl = lds + P_OFF_Q + wid * QLB;
    const bf16_t* Qw = Qb + (long)(wid * QBLK + r32) * ldq + hi * 8;
#pragma unroll
    for (int d0 = 0; d0 < DQK / 16; ++d0) { if (QL && d0 >= 4 && d0 < 8) *reinterpret_cast<bf16x8*>(qrl + k2swz(r32, ((d0 - 4) * 16 + hi * 8) * 2)) = *reinterpret_cast<const bf16x8*>(Qw + d0 * 16);
        else qr[d0] = *reinterpret_cast<const bf16x8*>(Qw + d0 * 16); }
    if constexpr (DQK == 192) {
        const float* rp = ropeq + (long)(wid * QBLK + r32) * 64;
#pragma unroll
        for (int pr = 0; pr < 2; ++pr) {
            const u32x4 x1 = *reinterpret_cast<const u32x4*>(&qr[8 + pr]), x2 = *reinterpret_cast<const u32x4*>(&qr[10 + pr]); u32x4 y1, y2;
#pragma unroll
            for (int w = 0; w < 4; ++w) { const f32x4 cs = *(const f32x4*)(rp + (pr * 16 + hi * 8 + 2 * w) * 2);
                const float a0 = bf_lo(x1[w]), a1 = bf_hi(x1[w]), b0 = bf_lo(x2[w]), b1 = bf_hi(x2[w]);
                y1[w] = cvtpk(a0 * cs[0] - b0 * cs[1], a1 * cs[2] - b1 * cs[3]); y2[w] = cvtpk(b0 * cs[0] + a0 * cs[1], b1 * cs[2] + a1 * cs[3]); }
            qr[8 + pr] = *reinterpret_cast<const bf16x8*>(&y1); qr[10 + pr] = *reinterpret_cast<const bf16x8*>(&y2);
        }
    }
    unsigned cls_pack = 0; int pq = 0; float bneg2 = 0.f, bpos2 = 0.f;
    if constexpr (BIAS) {
        const int qg = (q0 >> 5) + wid; const int qmin = pmmb[2 * qg], qmax = pmmb[2 * qg + 1];
#pragma unroll
        for (int t4 = 0; t4 < 4; ++t4) { const int tl = lane * 4 + t4;
            const i32x4 mm = *(const i32x4*)(pmmb + 4 * tl); const int kmin = mm[0] < mm[2] ? mm[0] : mm[2], kmax = mm[1] > mm[3] ? mm[1] : mm[3];
            const unsigned c = (kmin - qmax >= 91) ? 1u : ((qmin - kmax >= 91) ? 0u : 2u); cls_pack |= c << (2 * t4); }
        pq = posb[q0 + wid * QBLK + r32];
        for (int i = tid; i < 257; i += 512) lut[i] = lutg[i];
        bneg2 = lutg[0]; bpos2 = lutg[256];
    }
    const int sr = tid >> 4, sc = (tid & 15) * 8, vst0 = v_st(sr, sc), vst1 = v_st(32 + sr, sc);
    const int s2r = tid >> 3, s2c = (tid & 7) * 8;
    const int vb0 = (int)(uintptr_t)V_lds + v_rd_base(lane);
    const int kb0 = (int)(uintptr_t)K_lds + r32 * KP + hi * 16, k2b0 = (int)(uintptr_t)K2_lds + r32 * K2P + hi * 16, qlb0 = (int)(uintptr_t)qrl + r32 * K2P + hi * 16;
    const unsigned vo0 = (unsigned)(sr * ldv + sc) * 2u, vo1 = vo0 + (unsigned)(32 * ldv) * 2u, ko0 = (unsigned)(sr * ldk1 + sc) * 2u, ko1 = ko0 + (unsigned)(32 * ldk1) * 2u, k2o = (unsigned)(s2r * 64 + s2c) * 2u;
    bf16x8 sv[2 * NVH], sk0, sk1, sk2;
#define BAR() do { asm volatile("s_waitcnt lgkmcnt(0)" ::: "memory"); __builtin_amdgcn_s_barrier(); asm volatile("" ::: "memory"); } while (0)
#define KLOAD(t) do { const char* kt_ = (const char*)K1 + (size_t)(t) * KVBLK * ldk1 * 2; sk0 = *reinterpret_cast<const bf16x8*>(kt_ + ko0); sk1 = *reinterpret_cast<const bf16x8*>(kt_ + ko1); \
    if constexpr (DQK == 192) sk2 = *reinterpret_cast<const bf16x8*>((const char*)K2 + (size_t)(t) * KVBLK * 128 + k2o); } while (0)
#define VLOAD(t) do { const char* vt_ = (const char*)Vh + (size_t)(t) * KVBLK * ldv * 2; _Pragma("unroll") for (int h_ = 0; h_ < NVH; ++h_) { \
    sv[2 * h_] = *reinterpret_cast<const bf16x8*>(vt_ + vo0 + (size_t)h_ * (SEQ * 256)); sv[2 * h_ + 1] = *reinterpret_cast<const bf16x8*>(vt_ + vo1 + (size_t)h_ * (SEQ * 256)); } } while (0)
#define KWRITE(b) do { *(bf16x8*)(K_lds + (b) * SHM_K + kswz(sr, sc * 2)) = sk0; *(bf16x8*)(K_lds + (b) * SHM_K + kswz(32 + sr, sc * 2)) = sk1; \
    if constexpr (DQK == 192) *(bf16x8*)(K2_lds + (b) * SHM_K2 + k2swz(s2r, s2c * 2)) = sk2; } while (0)
#define VWRITE(b) do { _Pragma("unroll") for (int h_ = 0; h_ < NVH; ++h_) { *(bf16x8*)(V_lds + (b) * SHM_VX + h_ * 16384 + vst0) = sv[2 * h_]; *(bf16x8*)(V_lds + (b) * SHM_VX + h_ * 16384 + vst1) = sv[2 * h_ + 1]; } } while (0)
#define TCLS(t, TB, SL) do { if constexpr (BIAS) { const unsigned cw_ = (unsigned)__builtin_amdgcn_readlane((int)cls_pack, (t) >> 2); const unsigned c_ = (cw_ >> (2 * ((t) & 3))) & 3u; \
    SL = (c_ == 2u); TB = (c_ == 1u) ? bpos2 : bneg2; } else { SL = false; TB = 0.f; } } while (0)
    const int NT = seq / KVBLK;
    KLOAD(0); VLOAD(0); KWRITE(0); VWRITE(0); BAR();
    KLOAD(1); if constexpr (EARLY) VLOAD(1);
    if (half && PP_STAGGER) BAR();
    f32x16 p0, p1; float al, tbx; bool slx; bf16x8 pa0, pa1, pa2, pa3;
    for (int j = 0; j < NT; ++j) {
        const int b = j & 1;
        qkt_pipe<DQK, QL>(p0, p1, kb0 + b * SHM_K, k2b0 + b * SHM_K2, qlb0, qr);
        float cmx, offx;
        TCLS(j, tbx, slx); partialSM<BIAS, true>(p0, p1, m_reg, al, C, tbx, slx, posb + j * KVBLK, pq, lut, hi, &cmx, &offx);
        if (__any(al < 1.f)) { if (hi == 0) al_l[r32] = al; asm volatile("s_waitcnt lgkmcnt(0)" ::: "memory");
#pragma unroll
            for (int d = 0; d < 4 * NVH; ++d)
#pragma unroll
                for (int r = 0; r < 16; ++r) o[d][r] *= al_l[crow(r, hi)]; }
        if (j + 1 < NT) { KWRITE(b ^ 1); if constexpr (EARLY) { if (j + 2 < NT) KLOAD(j + 2); } else VLOAD(j + 1); }
        if (PP_STAGGER) BAR();
        {
            constexpr int NB = 4 * NVH, EPB = 16 / NB; const int vb_ = vb0 + b * SHM_VX;
            float ps = 0.f;
#pragma unroll
            for (int r = 0; r < 16; ++r) ps += p0[r];
            pa0 = pk8<0>(p0); pa1 = pk8<8>(p0);
            s16x4 L[2][2], H[2][2];
#define PK(L_, H_) (bf16x8){L_[0], L_[1], L_[2], L_[3], H_[0], H_[1], H_[2], H_[3]}
#define PVBLK(B, KS0, PX, PY) do { if constexpr ((B) + 1 < NB) pv_rd2<((B) + 1 < NB ? (B) + 1 : 0), KS0>(L[((B) + 1) & 1], H[((B) + 1) & 1], vb_); waitl<((B) + 1 < NB) ? 4 : 0>(); SBAR(); \
    o[B] = __builtin_amdgcn_mfma_f32_32x32x16_bf16(PX, PK(L[(B) & 1][0], H[(B) & 1][0]), o[B], 0, 0, 0); o[B] = __builtin_amdgcn_mfma_f32_32x32x16_bf16(PY, PK(L[(B) & 1][1], H[(B) & 1][1]), o[B], 0, 0, 0); SBAR(); } while (0)
#define SMCHUNK(B) do { _Pragma("unroll") for (int r_ = (B) * EPB; r_ < (B) * EPB + EPB; ++r_) { p1[r_] = __builtin_amdgcn_exp2f(fmaf(p1[r_], cmx, offx)); ps += p1[r_]; } \
    if constexpr ((B) * EPB + EPB == 8) pa2 = pk8<0>(p1); SBAR(); } while (0)
            SBAR(); pv_rd2<0, 0>(L[0], H[0], vb_);
            PVBLK(0, 0, pa0, pa1); SMCHUNK(0); PVBLK(1, 0, pa0, pa1); SMCHUNK(1); PVBLK(2, 0, pa0, pa1); SMCHUNK(2); PVBLK(3, 0, pa0, pa1); SMCHUNK(3);
            if constexpr (NB == 8) { PVBLK(4, 0, pa0, pa1); SMCHUNK(4); PVBLK(5, 0, pa0, pa1); SMCHUNK(5); PVBLK(6, 0, pa0, pa1); SMCHUNK(6); PVBLK(7, 0, pa0, pa1); SMCHUNK(7); }
            pa3 = pk8<8>(p1);
            { auto rr = __builtin_amdgcn_permlane32_swap(__float_as_uint(ps), __float_as_uint(ps), false, false); ps = __uint_as_float(rr[0]) + __uint_as_float(rr[1]); }
            l_reg = l_reg * al + ps;
            SBAR(); pv_rd2<0, 2>(L[0], H[0], vb_);
            PVBLK(0, 2, pa2, pa3); PVBLK(1, 2, pa2, pa3); PVBLK(2, 2, pa2, pa3); PVBLK(3, 2, pa2, pa3);
            if constexpr (NB == 8) { PVBLK(4, 2, pa2, pa3); PVBLK(5, 2, pa2, pa3); PVBLK(6, 2, pa2, pa3); PVBLK(7, 2, pa2, pa3); }
#undef PK
#undef PVBLK
#undef SMCHUNK
        }
        if (j + 1 < NT) { VWRITE(b ^ 1); if (j + 2 < NT) { if constexpr (EARLY) VLOAD(j + 2); else KLOAD(j + 2); } }
        BAR();
    }
    if (!half && PP_STAGGER) BAR();
    if (hi == 0) li_l[r32] = l_reg; asm volatile("s_waitcnt lgkmcnt(0)" ::: "memory");
    float rli[16];
#pragma unroll
    for (int r = 0; r < 16; ++r) rli[r] = __builtin_amdgcn_rcpf(li_l[crow(r, hi)]);
    bf16_t* stg = (bf16_t*)(lds + wid * (32 * DV * 2));
#pragma unroll
    for (int r = 0; r < 16; ++r) { const int orow = crow(r, hi);
#pragma unroll
        for (int d0 = 0; d0 < 4 * NVH; ++d0) stg[orow * DV + d0 * 32 + r32] = (bf16_t)f2bf(o[d0][r] * rli[r]); }
    asm volatile("s_waitcnt lgkmcnt(0)" ::: "memory");
    bf16_t* Ow = Ob + (long)(wid * QBLK) * ldo;
    constexpr int CPR = DV / 8, RPI = 64 / CPR;
#pragma unroll
    for (int i = 0; i < 32 / RPI; ++i) { const int row = i * RPI + lane / CPR, ch = lane % CPR; const u32x4 v = *(const u32x4*)(stg + row * DV + ch * 8); *(u32x4*)(Ow + (long)row * ldo + ch * 8) = v; }
    __syncthreads();
#undef BAR
#undef KLOAD
#undef VLOAD
#undef KWRITE
#undef VWRITE
#undef TCLS
}

template <int V> struct IC { static constexpr int value = V; };
template <int I, int KOFF, int K2OFF> __device__ __forceinline__ void qk3_rd(bf16x8& fa, bf16x8& fb, int kbuf, int krel, int k2buf, int k2rel) {
    if constexpr (I < 8) { const int a = kbuf + (krel ^ (I << 5)); fa = rd128<KOFF>(a); fb = rd128<KOFF + 8192>(a); }
    else { const int a = k2buf + (k2rel ^ ((I - 8) << 5)); fa = rd128<K2OFF>(a); fb = rd128<K2OFF + 4096>(a); }
}
template <int NI, int I, int KOFF, int K2OFF> __device__ __forceinline__ void qk3_steps(f32x16& p0, f32x16& p1, const f32x16& cinit, int kbuf, int krel, int k2buf, int k2rel, const bf16x8* qr, bf16x8& a0, bf16x8& b0, bf16x8& a1, bf16x8& b1, bf16x8& a2, bf16x8& b2) {
    if constexpr (I + 2 < NI) qk3_rd<I + 2, KOFF, K2OFF>(a2, b2, kbuf, krel, k2buf, k2rel);
    waitl<(I + 2 < NI) ? 4 : ((I + 1 < NI) ? 2 : 0)>(); SBAR();
    if constexpr (I == 0) { p0 = __builtin_amdgcn_mfma_f32_32x32x16_bf16(a0, qr[I], cinit, 0, 0, 0); p1 = __builtin_amdgcn_mfma_f32_32x32x16_bf16(b0, qr[I], cinit, 0, 0, 0); }
    else { p0 = __builtin_amdgcn_mfma_f32_32x32x16_bf16(a0, qr[I], p0, 0, 0, 0); p1 = __builtin_amdgcn_mfma_f32_32x32x16_bf16(b0, qr[I], p1, 0, 0, 0); }
    SBAR();
    if constexpr (I + 1 < NI) qk3_steps<NI, I + 1, KOFF, K2OFF>(p0, p1, cinit, kbuf, krel, k2buf, k2rel, qr, a1, b1, a2, b2, a0, b0);
}
typedef short v4i16_t __attribute__((ext_vector_type(4)));
__device__ __forceinline__ s16x4 vtr(const LAS unsigned char* p) { return __builtin_bit_cast(s16x4, __builtin_amdgcn_ds_read_tr16_b64_v4i16((LAS v4i16_t*)p)); }
template <int BLK, int KS0> __device__ __forceinline__ void pv_rd2c(s16x4 (&L)[2], s16x4 (&H)[2], const LAS unsigned char* vp) {
    constexpr int base = (BLK >> 2) * 16384, D0 = BLK & 3;
    L[0] = vtr(vp + base + v_rd_off(D0, KS0, 0)); H[0] = vtr(vp + base + v_rd_off(D0, KS0, 1)); L[1] = vtr(vp + base + v_rd_off(D0, KS0 + 1, 0)); H[1] = vtr(vp + base + v_rd_off(D0, KS0 + 1, 1));
}
__device__ __forceinline__ void glds_s(const void* sbase, unsigned voff, unsigned ldsaddr) {
    unsigned keep;
    asm volatile("s_mov_b32 %0, m0\n\ts_mov_b32 m0, %3\n\ts_nop 0\n\tglobal_load_lds_dwordx4 %1, %2\n\ts_mov_b32 m0, %0" : "=&s"(keep) : "v"(voff), "s"(sbase), "s"(ldsaddr) : "memory");
}
struct FuseArgs { const bf16_t* O0; bf16_t* Hout; const float* g; float lam, oml; };
template <int DQK, int DV, bool BIAS, bool FUSE = false>
__device__ __forceinline__ void attn_unit_dma(const bf16_t* __restrict__ Qb, int ldq, const bf16_t* __restrict__ K1, int ldk1, const bf16_t* __restrict__ K2, const bf16_t* __restrict__ Vh, int ldv, bf16_t* __restrict__ Ob, int ldo,
                                              const float* __restrict__ ropeq, const int* __restrict__ posb, const int* __restrict__ pmmb, int q0, const float* __restrict__ lutg, float C, int seq, char* lds, LAS unsigned char* ldsl, const int tid, const FuseArgs fa = FuseArgs{}) {
    constexpr bool NEGM = true, NEGP = (DV == 128);
    constexpr int NVH = DV / 128, SHM_VX = 16384 * NVH, SHM_KD = 16384, SHM_K2D = 8192, P_OFF_V = 0, P_OFF_K = 2 * SHM_VX, P_OFF_K2 = P_OFF_K + 2 * SHM_KD;
    static_assert(P_OFF_K2 + (DQK == 192 ? 2 * SHM_K2D : 0) <= PP_OFF_WS && NW * 32 * DV * 2 <= PP_OFF_WS, "dma LDS map");
    const int wid = tid >> 6, lane = tid & 63, r32 = lane & 31, hi = lane >> 5; const int widu = __builtin_amdgcn_readfirstlane(wid);
    char* V_lds = lds + P_OFF_V; char* K_lds = lds + P_OFF_K;
    float* ws = (float*)(lds + PP_OFF_WS) + widu * 64; float* li_l = ws; float* al_l = ws + 32; float* lut = (float*)(lds + PP_OFF_LUT);
    float m_reg = NEGM ? 0.f : -1e30f, l_reg = 0; f32x16 o[4 * NVH] = {}; bf16x8 qr[DQK / 16];
    const bf16_t* Qw = Qb + (long)(wid * QBLK + r32) * ldq + hi * 8;
#pragma unroll
    for (int d0 = 0; d0 < DQK / 16; ++d0) qr[d0] = *reinterpret_cast<const bf16x8*>(Qw + d0 * 16);
    if constexpr (DQK == 192) {
        const float* rp = ropeq + (long)(wid * QBLK + r32) * 64;
#pragma unroll
        for (int pr = 0; pr < 2; ++pr) {
            const u32x4 x1 = *reinterpret_cast<const u32x4*>(&qr[8 + pr]), x2 = *reinterpret_cast<const u32x4*>(&qr[10 + pr]); u32x4 y1, y2;
#pragma unroll
            for (int w = 0; w < 4; ++w) { const f32x4 cs = *(const f32x4*)(rp + (pr * 16 + hi * 8 + 2 * w) * 2);
                const float a0 = bf_lo(x1[w]), a1 = bf_hi(x1[w]), b0 = bf_lo(x2[w]), b1 = bf_hi(x2[w]);
                y1[w] = cvtpk(a0 * cs[0] - b0 * cs[1], a1 * cs[2] - b1 * cs[3]); y2[w] = cvtpk(b0 * cs[0] + a0 * cs[1], b1 * cs[2] + a1 * cs[3]); }
            qr[8 + pr] = *reinterpret_cast<const bf16x8*>(&y1); qr[10 + pr] = *reinterpret_cast<const bf16x8*>(&y2);
        }
    }
    if constexpr (NEGM)
#pragma unroll
    for (int d0 = 0; d0 < DQK / 16; ++d0) {
        const u32x4 x = *reinterpret_cast<const u32x4*>(&qr[d0]); u32x4 y;
#pragma unroll
        for (int w = 0; w < 4; ++w) y[w] = cvtpk(bf_lo(x[w]) * C, bf_hi(x[w]) * C);
        qr[d0] = *reinterpret_cast<const bf16x8*>(&y); }
    unsigned cls_pack = 0; int pq = 0; float bneg2 = 0.f, bpos2 = 0.f;
    if constexpr (BIAS) {
        const int qg = (q0 >> 5) + wid; const int qmin = pmmb[2 * qg], qmax = pmmb[2 * qg + 1];
#pragma unroll
        for (int t4 = 0; t4 < 4; ++t4) { const int tl = lane * 4 + t4;
            const i32x4 mm = *(const i32x4*)(pmmb + 4 * tl); const int kmin = mm[0] < mm[2] ? mm[0] : mm[2], kmax = mm[1] > mm[3] ? mm[1] : mm[3];
            const unsigned c = (kmin - qmax >= 91) ? 1u : ((qmin - kmax >= 91) ? 0u : 2u); cls_pack |= c << (2 * t4); }
        pq = posb[q0 + wid * QBLK + r32];
        for (int i = tid; i < 257; i += 512) lut[i] = lutg[i];
        bneg2 = __builtin_bit_cast(float, __builtin_amdgcn_readfirstlane(__builtin_bit_cast(int, lutg[0]))); bpos2 = __builtin_bit_cast(float, __builtin_amdgcn_readfirstlane(__builtin_bit_cast(int, lutg[256])));
    }
    const int krow = 4 * wid + (lane >> 4), kfw = (krow & 7) | (((krow >> 4) & 1) << 3);
    const unsigned kof = (unsigned)krow * (unsigned)(ldk1 * 2) + (unsigned)(((lane & 15) ^ kfw) << 4);
    const int vsub = 2 * wid + (lane >> 5), vk = (vsub >> 2) * 8 + ((lane & 31) >> 2);
    const unsigned vof = (unsigned)vk * (unsigned)(ldv * 2) + (unsigned)(((vsub & 3) * 32 + (lane & 3) * 8) * 2);
    const int k2row = 8 * wid + (lane >> 3); const unsigned k2of = (unsigned)k2row * 128u + (unsigned)(((lane & 7) ^ ((k2row >> 1) & 7)) << 4);
    const int k2rel = r32 * 128 + ((hi ^ ((r32 >> 1) & 7)) << 4), k2buf0 = (int)(uintptr_t)(lds + P_OFF_K2);
    const int vb0 = (int)(uintptr_t)V_lds + v_rd_base(lane);
    const unsigned ldsb = (unsigned)(uintptr_t)ldsl;
    const int kfr = (r32 & 7) | (((r32 >> 4) & 1) << 3), krel = r32 * 256 + ((hi ^ kfr) << 4), kbuf0 = (int)(uintptr_t)K_lds;
#define DMA(t, b) do { const char* kt_ = (const char*)K1 + (size_t)(t) * KVBLK * ldk1 * 2; const char* vt_ = (const char*)Vh + (size_t)(t) * KVBLK * ldv * 2; \
    const unsigned kd_ = ldsb + P_OFF_K + (b) * SHM_KD + widu * 1024; glds_s(kt_, kof, kd_); glds_s(kt_ + 32 * ldk1 * 2, kof, kd_ + 8192); \
    if constexpr (DQK == 192) glds_s((const char*)K2 + (size_t)(t) * KVBLK * 128, k2of, ldsb + P_OFF_K2 + (b) * SHM_K2D + widu * 1024); \
    _Pragma("unroll") for (int h_ = 0; h_ < NVH; ++h_) { const unsigned vd_ = ldsb + P_OFF_V + (b) * SHM_VX + h_ * 16384 + widu * 1024; \
        glds_s(vt_ + (size_t)h_ * (SEQ * 256), vof, vd_); glds_s(vt_ + 32 * ldv * 2 + (size_t)h_ * (SEQ * 256), vof, vd_ + 8192); } } while (0)
#define BARV() do { asm volatile("s_waitcnt vmcnt(0) lgkmcnt(0)" ::: "memory"); __builtin_amdgcn_s_barrier(); asm volatile("" ::: "memory"); } while (0)
#define TCLS(t, TB, SL) do { if constexpr (BIAS) { const unsigned cw_ = (unsigned)__builtin_amdgcn_readlane((int)cls_pack, (t) >> 2); const unsigned c_ = (cw_ >> (2 * ((t) & 3))) & 3u; \
    SL = (c_ == 2u); TB = (c_ == 1u) ? bpos2 : bneg2; } else { SL = false; TB = 0.f; } } while (0)
    const int NT = seq / KVBLK;
    if (widu >= 4) __builtin_amdgcn_s_setprio(1);
    DMA(0, 0); BARV();
    f32x16 p0, p1, negm = {}; float al, tbx, negv = 0.f; bool slx; bf16x8 pa0, pa1, pa2, pa3;
    auto tile = [&](auto BC, const int j) __attribute__((always_inline)) {
        constexpr bool CB = true;
        const int b = CB ? decltype(BC)::value : (j & 1);
        TCLS(j, tbx, slx);
        const bool chk = ((j & 7) == 0) || slx;
        float cmx = 1.f, offx = 0.f;
        if constexpr (NEGM) {
            { const float want = (slx ? 0.f : tbx) - m_reg;
              if (!NEGP || __builtin_expect(__any(want != negv), 0)) { negv = want;
#pragma unroll
                  for (int r = 0; r < 16; ++r) negm[r] = want; } }
            { bf16x8 a0, b0, a1, b1, a2, b2; constexpr int KO = CB ? decltype(BC)::value * SHM_KD : 0, K2O = CB ? decltype(BC)::value * SHM_K2D : 0;
              const int kbuf = kbuf0 + (CB ? 0 : b * SHM_KD), k2buf = k2buf0 + (CB ? 0 : b * SHM_K2D);
              SBAR(); qk3_rd<0, KO, K2O>(a0, b0, kbuf, krel, k2buf, k2rel); qk3_rd<1, KO, K2O>(a1, b1, kbuf, krel, k2buf, k2rel);
              qk3_steps<DQK / 16, 0, KO, K2O>(p0, p1, negm, kbuf, krel, k2buf, k2rel, qr, a0, b0, a1, b1, a2, b2); }
            if (j + 1 < NT) DMA(j + 1, b ^ 1);
            smFront<BIAS>(p0, p1, m_reg, al, slx, j == 0, posb + j * KVBLK, pq, lut, hi, chk);
        } else {
            { const f32x16 zc = {}; bf16x8 a0, b0, a1, b1, a2, b2; constexpr int KO = CB ? decltype(BC)::value * SHM_KD : 0, K2O = CB ? decltype(BC)::value * SHM_K2D : 0;
              const int kbuf = kbuf0 + (CB ? 0 : b * SHM_KD), k2buf = k2buf0 + (CB ? 0 : b * SHM_K2D);
              SBAR(); qk3_rd<0, KO, K2O>(a0, b0, kbuf, krel, k2buf, k2rel); qk3_rd<1, KO, K2O>(a1, b1, kbuf, krel, k2buf, k2rel);
              qk3_steps<DQK / 16, 0, KO, K2O>(p0, p1, zc, kbuf, krel, k2buf, k2rel, qr, a0, b0, a1, b1, a2, b2); }
            if (j + 1 < NT) DMA(j + 1, b ^ 1);
            partialSM<BIAS, true>(p0, p1, m_reg, al, C, tbx, slx, posb + j * KVBLK, pq, lut, hi, &cmx, &offx, chk);
        }
        if (chk && __any(al < 1.f)) {
            unsigned on_ = ~0u; asm volatile("" : "+s"(on_)); const int ln_ = (int)__builtin_amdgcn_mbcnt_hi(on_, __builtin_amdgcn_mbcnt_lo(on_, 0u)), hi_ = ln_ >> 5;
            if (hi_ == 0) al_l[ln_] = al; asm volatile("s_waitcnt lgkmcnt(0)" ::: "memory");
#pragma unroll
            for (int d = 0; d < 4 * NVH; ++d)
#pragma unroll
                for (int r = 0; r < 16; ++r) o[d][r] *= al_l[crow(r, hi_)]; }
        {
            constexpr int NB = 4 * NVH, EPB = 16 / NB; const int vb_ = vb0 + b * SHM_VX;
            float ps = 0.f;
#pragma unroll
            for (int r = 0; r < 16; ++r) ps += p0[r];
            pa0 = pk8r<0>(p0); pa1 = pk8r<8>(p0);
            s16x4 L[2][2], H[2][2]; const LAS unsigned char* vp_ = ldsl + P_OFF_V + b * SHM_VX + v_rd_base(lane);
#define PK(L_, H_) (bf16x8){L_[0], L_[1], L_[2], L_[3], H_[0], H_[1], H_[2], H_[3]}
#define PVBLK(B, KS0, PX, PY) do { if constexpr ((B) + 1 < NB) pv_rd2c<((B) + 1 < NB ? (B) + 1 : 0), KS0>(L[((B) + 1) & 1], H[((B) + 1) & 1], vp_); SBAR(); \
    o[B] = __builtin_amdgcn_mfma_f32_32x32x16_bf16(PX, PK(L[(B) & 1][0], H[(B) & 1][0]), o[B], 0, 0, 0); o[B] = __builtin_amdgcn_mfma_f32_32x32x16_bf16(PY, PK(L[(B) & 1][1], H[(B) & 1][1]), o[B], 0, 0, 0); SBAR(); } while (0)
#define SMCHUNK(B) do { _Pragma("unroll") for (int r_ = (B) * EPB; r_ < (B) * EPB + EPB; ++r_) { p1[r_] = __builtin_amdgcn_exp2f(NEGM ? p1[r_] : fmaf(p1[r_], cmx, offx)); ps += p1[r_]; } \
    if constexpr ((B) * EPB + EPB == 8) pa2 = pk8r<0>(p1); SBAR(); } while (0)
            SBAR(); pv_rd2c<0, 0>(L[0], H[0], vp_);
            PVBLK(0, 0, pa0, pa1); SMCHUNK(0); PVBLK(1, 0, pa0, pa1); SMCHUNK(1); PVBLK(2, 0, pa0, pa1); SMCHUNK(2); PVBLK(3, 0, pa0, pa1); SMCHUNK(3);
            if constexpr (NB == 8) { PVBLK(4, 0, pa0, pa1); SMCHUNK(4); PVBLK(5, 0, pa0, pa1); SMCHUNK(5); PVBLK(6, 0, pa0, pa1); SMCHUNK(6); PVBLK(7, 0, pa0, pa1); SMCHUNK(7); }
            pa3 = pk8r<8>(p1);
            { auto rr = __builtin_amdgcn_permlane32_swap(__float_as_uint(ps), __float_as_uint(ps), false, false); ps = __uint_as_float(rr[0]) + __uint_as_float(rr[1]); }
            l_reg = l_reg * al + ps;
            SBAR(); pv_rd2c<0, 2>(L[0], H[0], vp_);
            PVBLK(0, 2, pa2, pa3); PVBLK(1, 2, pa2, pa3); PVBLK(2, 2, pa2, pa3); PVBLK(3, 2, pa2, pa3);
            if constexpr (NB == 8) { PVBLK(4, 2, pa2, pa3); PVBLK(5, 2, pa2, pa3); PVBLK(6, 2, pa2, pa3); PVBLK(7, 2, pa2, pa3); }
#undef PK
#undef PVBLK
#undef SMCHUNK
        }
        BARV();
    };
    for (int jj = 0; jj < NT; jj += 2) { tile(IC<0>{}, jj); tile(IC<1>{}, jj + 1); }
    __builtin_amdgcn_s_setprio(0);
    unsigned ones_e = ~0u; asm volatile("" : "+s"(ones_e)); int lane_e = (int)__builtin_amdgcn_mbcnt_hi(ones_e, __builtin_amdgcn_mbcnt_lo(ones_e, 0u)); asm volatile("" : "+v"(lane_e));
    const int r32e = lane_e & 31, hie = lane_e >> 5;
    if (hie == 0) li_l[r32e] = l_reg; asm volatile("s_waitcnt lgkmcnt(0)" ::: "memory");
    float rli[16];
#pragma unroll
    for (int r = 0; r < 16; ++r) rli[r] = __builtin_amdgcn_rcpf(li_l[crow(r, hie)]);
    bf16_t* stg = (bf16_t*)(lds + widu * (32 * DV * 2));
#pragma unroll
    for (int r = 0; r < 16; ++r) { const int orow = crow(r, hie);
#pragma unroll
        for (int d0 = 0; d0 < 4 * NVH; ++d0) stg[orow * DV + d0 * 32 + r32e] = (bf16_t)f2bf(o[d0][r] * rli[r]); }
    asm volatile("s_waitcnt lgkmcnt(0)" ::: "memory");
    constexpr int CPR = DV / 8, RPI = 64 / CPR;
    if constexpr (FUSE) {
        static_assert(DV == 256, "FUSE: one head = 256 value columns = 32 lanes x 8");
        const bf16_t* O0w = fa.O0 + (long)(widu * QBLK) * ldo; bf16_t* Hw = fa.Hout + (long)(widu * QBLK) * DM;
        const int ch = lane_e & 31; const float* gg = fa.g + ch * 8;
        const f32x4 g0 = *(const f32x4*)gg, g1 = *(const f32x4*)(gg + 4);
#pragma unroll 4
        for (int i = 0; i < 16; ++i) { const int row = i * 2 + (lane_e >> 5);
            const u32x4 b2 = *(const u32x4*)(stg + row * DV + ch * 8), a = *(const u32x4*)(O0w + (long)row * ldo + ch * 8);
            float d[8] = {bf_lo(a.x) - fa.lam * bf_lo(b2.x), bf_hi(a.x) - fa.lam * bf_hi(b2.x), bf_lo(a.y) - fa.lam * bf_lo(b2.y), bf_hi(a.y) - fa.lam * bf_hi(b2.y),
                          bf_lo(a.z) - fa.lam * bf_lo(b2.z), bf_hi(a.z) - fa.lam * bf_hi(b2.z), bf_lo(a.w) - fa.lam * bf_lo(b2.w), bf_hi(a.w) - fa.lam * bf_hi(b2.w)};
            float ss = 0.f;
#pragma unroll
            for (int e = 0; e < 8; ++e) ss += d[e] * d[e];
#pragma unroll
            for (int o_ = 1; o_ < 32; o_ <<= 1) ss += shfl_xor_l(ss, o_, lane_e);
            const float r = rsqrtf(ss * (1.f / 256.f) + EPS) * fa.oml;
            u32x4 w; w.x = pk2(d[0] * r * g0[0], d[1] * r * g0[1]); w.y = pk2(d[2] * r * g0[2], d[3] * r * g0[3]); w.z = pk2(d[4] * r * g1[0], d[5] * r * g1[1]); w.w = pk2(d[6] * r * g1[2], d[7] * r * g1[3]);
            *(u32x4*)(Hw + (long)row * DM + ch * 8) = w; }
    } else {
        bf16_t* Ow = Ob + (long)(widu * QBLK) * ldo;
#pragma unroll
        for (int i = 0; i < 32 / RPI; ++i) { const int row = i * RPI + lane_e / CPR, ch = lane_e % CPR; const u32x4 v = *(const u32x4*)(stg + row * DV + ch * 8); *(u32x4*)(Ow + (long)row * ldo + ch * 8) = v; }
        asm volatile("s_waitcnt vmcnt(0)" ::: "memory");
    }
    __syncthreads();
#undef DMA
#undef BARV
#undef TCLS
}
#undef SBAR
}

__device__ __forceinline__ void p0_transpose_item(const float* W, int K, int N, bf16_t* WT, LAS float* scr, int item, int lane) {
    const int nblk = N / 32, kb = item / nblk, nb = item % nblk, k0 = 64 * kb, n0 = 32 * nb;
#pragma unroll 8
    for (int i = 0; i < 32; ++i) { const int kk = 2 * i + (lane >> 5); scr[kk * 33 + (lane & 31)] = W[(size_t)(k0 + kk) * N + n0 + (lane & 31)]; }
    asm volatile("s_waitcnt lgkmcnt(0)" ::: "memory");
    const int c = lane & 7;
#pragma unroll
    for (int j = 0; j < 4; ++j) { const int n = (lane >> 3) + 8 * j; const LAS float* s = scr + (8 * c) * 33 + n;
        u32x4 o; o.x = pk2(s[0 * 33], s[1 * 33]); o.y = pk2(s[2 * 33], s[3 * 33]); o.z = pk2(s[4 * 33], s[5 * 33]); o.w = pk2(s[6 * 33], s[7 * 33]);
        *(u32x4*)(WT + (size_t)(n0 + n) * K + k0 + 8 * c) = o; }
    asm volatile("s_waitcnt lgkmcnt(0)" ::: "memory");
}

struct Args { const void* in[20]; float* out; unsigned char* ws; int ph_lo, ph_hi, coop, pad; };

__device__ __forceinline__ void norm_mod_rows(const float* __restrict__ X, const float* __restrict__ modl  , int sh_off, int sc_off, bf16_t* __restrict__ H, int gw, int NGW, int lane) {
    f32x4 v[8], nx[8];
    if (gw < MTOK) { const f32x4* xr = (const f32x4*)(X + (size_t)gw * DM) + 2 * lane;
#pragma unroll
        for (int j = 0; j < 4; ++j) { v[2 * j] = xr[128 * j]; v[2 * j + 1] = xr[128 * j + 1]; } }
    for (int m = gw; m < MTOK; m += NGW) {
        const int mn = m + NGW;
        if (mn < MTOK) { const f32x4* xn = (const f32x4*)(X + (size_t)mn * DM) + 2 * lane;
#pragma unroll
            for (int j = 0; j < 4; ++j) { nx[2 * j] = xn[128 * j]; nx[2 * j + 1] = xn[128 * j + 1]; } }
        const float* mb = modl + (size_t)(m >> 14) * MODW;
        float s = 0.f;
#pragma unroll
        for (int j = 0; j < 8; ++j) s += (v[j].x * v[j].x + v[j].y * v[j].y) + (v[j].z * v[j].z + v[j].w * v[j].w);
        const float r = rsqrtf(wave_sum(s, lane) * (1.f / DM) + EPS);
        u32x4* o16 = (u32x4*)(H + (size_t)m * DM) + lane;
        const f32x4* scp = (const f32x4*)(mb + sc_off) + 2 * lane; const f32x4* shp = (const f32x4*)(mb + sh_off) + 2 * lane;
#pragma unroll
        for (int j = 0; j < 4; ++j) {
            const f32x4 y0 = (v[2 * j] * r) * (scp[128 * j] + 1.0f) + shp[128 * j], y1 = (v[2 * j + 1] * r) * (scp[128 * j + 1] + 1.0f) + shp[128 * j + 1];
            u32x4 w; w.x = pk2(y0.x, y0.y); w.y = pk2(y0.z, y0.w); w.z = pk2(y1.x, y1.y); w.w = pk2(y1.z, y1.w); o16[64 * j] = w; }
#pragma unroll
        for (int j = 0; j < 8; ++j) v[j] = nx[j];
    }
}

constexpr int N_PHASES = 22;
constexpr int LDS_BYTES = 160768;
static_assert(att::ATT_LDS <= LDS_BYTES && pg8::STAGE_BYTES <= LDS_BYTES && LDS_BYTES <= 163840, "LDS map");
typedef const __attribute__((address_space(4))) Args* KArgs;
#define PHASE_IDS() KArgs ka = (KArgs)__builtin_amdgcn_kernarg_segment_ptr(); asm volatile("" : "+s"(ka)); unsigned char* const ws = ka->ws; float* const out = ka->out; \
    unsigned ones_ = ~0u; asm volatile("" : "+s"(ones_)); int lane = (int)__builtin_amdgcn_mbcnt_hi(ones_, __builtin_amdgcn_mbcnt_lo(ones_, 0u)); asm volatile("" : "+v"(lane)); int vcu_o = vcu; asm volatile("" : "+s"(vcu_o)); const int tid = wave * 64 + lane, gw = vcu_o * 8 + wave; (void)gw; (void)ws; (void)out
#define IN_F(k) ((const float*)ka->in[k])
#define WSP(T, off) ((T*)(ws + (off)))
__global__ void __launch_bounds__(512) mk_fwd(Args args) {
    extern __shared__ __attribute__((aligned(16))) unsigned char lds[];
    const int wave = __builtin_amdgcn_readfirstlane((int)threadIdx.x >> 6);
    const int G = gridDim.x, bx = blockIdx.x; const int vcu = ((G & 7) == 0) ? (bx & 7) * (G >> 3) + (bx >> 3) : bx;
    const int NGW = G * 8;
    LAS unsigned char* ldsl = (LAS unsigned char*)lds;
    const int lo = args.ph_lo, hi = args.ph_hi, coop = args.coop;
#define IN(k) (lo <= (k) && (k) < hi)
#define SEAM(k) do { if (IN((k) + 1) && coop) { cg::this_grid().sync(); } } while (0)

    if (IN(0)) {
        PHASE_IDS();
        {
            const float* cvec = IN_F(1); const float* w_ada = IN_F(4); const float* b_ada = IN_F(5); float* MOD = WSP(float, CTL_MOD);
            LAS float* cs = (LAS float*)ldsl; LAS float* red = (LAS float*)(ldsl + 16384);
            for (int t = tid; t < BATCH * DM; t += 512) { const float c = cvec[t]; cs[t] = c / (1.f + __expf(-c)); }
            __syncthreads();
            for (int item = bx; item < 768; item += G) {
                const int l = item / 384, j0 = (item % 384) * 32, colq = tid & 7, ks = tid >> 3;
                const float* W = w_ada + (size_t)l * DM * MODW + j0 + colq * 4;
                f32x4 a0 = {0.f, 0.f, 0.f, 0.f}, a1 = {0.f, 0.f, 0.f, 0.f};
#pragma unroll 8
                for (int k = ks; k < DM; k += 64) { const f32x4 w = *(const f32x4*)(W + (size_t)k * MODW); a0 += w * cs[k]; a1 += w * cs[DM + k]; }
                LAS f32x4* rp = (LAS f32x4*)(red + (ks * 8 + colq) * 8); rp[0] = a0; rp[1] = a1;
                __syncthreads();
                if (tid < 64) { const int b = tid >> 5, c = tid & 31; float s = 0.f;
                    for (int k2 = 0; k2 < 64; ++k2) s += red[(k2 * 8 + (c >> 2)) * 8 + b * 4 + (c & 3)];
                    MOD[(size_t)(l * 2 + b) * MODW + j0 + c] = s + b_ada[(size_t)l * MODW + j0 + c]; }
                __syncthreads();
            }
        }
        {
            const int* positions = (const int*)ka->in[2]; const float* rel_bias = IN_F(3);
            const float* lq1 = IN_F(7); const float* lk1 = IN_F(8); const float* lq2 = IN_F(9); const float* lk2 = IN_F(10);
            float* LUT = WSP(float, CTL_LUT); float* LAM = WSP(float, CTL_LAM); int* PMM = WSP(int, CTL_PMM); float* ROPE = WSP(float, WS_ROPE); bf16_t* WIN = WSP(bf16_t, WS_WIN);
            const int gt = vcu * 512 + tid, NGT = G * 512;
            for (int i = gt; i < 4 * 257; i += NGT) { const int h = i / 257, idx = i % 257, rel = idx - 128, n = rel < 0 ? -rel : rel;
                int bk = n; if (n >= 8) { bk = 8 + (n >= 12) + (n >= 16) + (n >= 23) + (n >= 32) + (n >= 46) + (n >= 64) + (n >= 91); }
                if (rel > 0) bk += 16;
                LUT[i] = rel_bias[bk * 4 + h] * LOG2E; }
            if (gt < DEPTH) { const int l = gt; float s1 = 0.f, s2 = 0.f;
                for (int i = 0; i < 128; ++i) { s1 += lq1[l * 128 + i] * lk1[l * 128 + i]; s2 += lq2[l * 128 + i] * lk2[l * 128 + i]; }
                const float li = 0.8f - 0.6f * expf(-0.3f * (float)l);
                LAM[l] = expf(s1) - expf(s2) + li; LAM[2 + l] = 1.f - li; }
            for (int g = gt; g < MTOK / 32; g += NGT) { int mn = 0x7fffffff, mx = (int)0x80000000;
                for (int i = 0; i < 32; ++i) { const int p = positions[g * 32 + i]; mn = p < mn ? p : mn; mx = p > mx ? p : mx; }
                PMM[2 * g] = mn; PMM[2 * g + 1] = mx; }
            for (int i = gt; i < MTOK * 32; i += NGT) { const int m = i >> 5, f = i & 31;
                const float ang = (float)positions[m] * INV_FREQ[f];
                const double rev = (double)ang * 0.15915494309189535; const float fr = (float)(rev - __builtin_floor(rev));
                ((f32x2*)ROPE)[i] = (f32x2){__builtin_amdgcn_cosf(fr), __builtin_amdgcn_sinf(fr)}; }
            for (int i = gt; i < DEPTH * (IN_PAD - IN_COLS) * DM / 8; i += NGT) { const int l = i / ((IN_PAD - IN_COLS) * DM / 8), r = i % ((IN_PAD - IN_COLS) * DM / 8);
                *(u32x4*)(WIN + (size_t)l * IN_PAD * DM + (size_t)IN_COLS * DM + (size_t)r * 8) = (u32x4){0u, 0u, 0u, 0u}; }
        }
        __syncthreads();
        {
            LAS float* scr = (LAS float*)(ldsl + wave * 16384);
            constexpr int I_IN = (DM / 64) * (IN_COLS / 32), I_UQ = (QL / 64) * (NQM / 32), I_UKV = (KVL / 64) * (NKV / 32), I_O = (DM / 64) * (DM / 32), I_1 = (DM / 64) * (DFF / 32), I_2 = (DFF / 64) * (DM / 32);
            constexpr int PER_L = I_IN + I_UQ + I_UKV + I_O + I_1 + I_2;
            for (int it = gw; it < DEPTH * PER_L; it += NGW) {
                const int l = it / PER_L; int r = it % PER_L;
                if (r < I_IN) { p0_transpose_item(IN_F(6) + (size_t)l * DM * IN_COLS, DM, IN_COLS, WSP(bf16_t, WS_WIN) + (size_t)l * IN_PAD * DM, scr, r, lane); continue; } r -= I_IN;
                if (r < I_UQ) { p0_transpose_item(IN_F(13) + (size_t)l * QL * NQM, QL, NQM, WSP(bf16_t, WS_WUQ) + (size_t)l * NQM * QL, scr, r, lane); continue; } r -= I_UQ;
                if (r < I_UKV) { p0_transpose_item(IN_F(15) + (size_t)l * KVL * NKV, KVL, NKV, WSP(bf16_t, WS_WUKV) + (size_t)l * NKV * KVL, scr, r, lane); continue; } r -= I_UKV;
                if (r < I_O) { p0_transpose_item(IN_F(16) + (size_t)l * DM * DM, DM, DM, WSP(bf16_t, WS_WO) + (size_t)l * DM * DM, scr, r, lane); continue; } r -= I_O;
                if (r < I_1) { p0_transpose_item(IN_F(17) + (size_t)l * DM * DFF, DM, DFF, WSP(bf16_t, WS_W1) + (size_t)l * DFF * DM, scr, r, lane); continue; } r -= I_1;
                p0_transpose_item(IN_F(18) + (size_t)l * DFF * DM, DFF, DM, WSP(bf16_t, WS_W2) + (size_t)l * DM * DFF, scr, r, lane);
            }
        }
        __syncthreads();
        SEAM(0);
    }

    for (int l = 0; l < DEPTH; ++l) {
        const int pb = 1 + 10 * l;
        if (IN(pb + 0)) { PHASE_IDS(); norm_mod_rows((l == 0) ? IN_F(0) : out, WSP(float, CTL_MOD) + (size_t)l * 2 * MODW, 0 * DM, 1 * DM, WSP(bf16_t, WS_HB), gw, NGW, lane); SEAM(pb + 0); }
        if (IN(pb + 1)) {
            PHASE_IDS();
            pg8::Gemm g{WSP(bf16_t, WS_HB), WSP(bf16_t, WS_WIN) + (size_t)l * IN_PAD * DM, MTOK, IN_PAD, DM}; pg8::StaticOrder S; S.init(MTOK, IN_PAD, G, bx);
            pg8::EpiBf16<0, true> E{WSP(bf16_t, WS_PROJ), IN_PAD / 128};
            pg8::gemm_phase<pg8::EpiBf16<0, true>, pg8::StaticOrder, true, true>(ldsl, g, S, E, tid);
            SEAM(pb + 1);
        }
        if (IN(pb + 2)) {
            PHASE_IDS();
            const bf16_t* PROJ = WSP(bf16_t, WS_PROJ); bf16_t* CQN = WSP(bf16_t, WS_CQN); bf16_t* CKVN = WSP(bf16_t, WS_CKVN); bf16_t* KROPE = WSP(bf16_t, WS_KROPE);
            const float* ROPE = WSP(float, WS_ROPE); const float* qn_g = IN_F(12); const float* kvn_g = IN_F(14);
            for (int m = gw; m < MTOK; m += NGW) {
                const int bb = m >> 14, ss = m & 16383;
#define PH(head) (PROJ + ((size_t)(bb * 32 + (head)) * SEQ + ss) * 128)
                { const u32x4 w = *((const u32x4*)PH(24 + (lane >> 4)) + (lane & 15)); float v[8] = {bf_lo(w.x), bf_hi(w.x), bf_lo(w.y), bf_hi(w.y), bf_lo(w.z), bf_hi(w.z), bf_lo(w.w), bf_hi(w.w)};
                  float s = 0.f;
#pragma unroll
                  for (int e = 0; e < 8; ++e) s += v[e] * v[e];
                  const float r = rsqrtf(wave_sum(s, lane) * (1.f / QL) + EPS); const float* gq = qn_g + l * QL + lane * 8;
                  u32x4 o; o.x = pk2(v[0] * r * gq[0], v[1] * r * gq[1]); o.y = pk2(v[2] * r * gq[2], v[3] * r * gq[3]); o.z = pk2(v[4] * r * gq[4], v[5] * r * gq[5]); o.w = pk2(v[6] * r * gq[6], v[7] * r * gq[7]);
                  *((u32x4*)(CQN + (size_t)m * QL) + lane) = o; }
                { const u32x2 w = *((const u32x2*)PH(28 + (lane >> 5)) + (lane & 31)); float v[4] = {bf_lo(w.x), bf_hi(w.x), bf_lo(w.y), bf_hi(w.y)};
                  float s = (v[0] * v[0] + v[1] * v[1]) + (v[2] * v[2] + v[3] * v[3]);
                  const float r = rsqrtf(wave_sum(s, lane) * (1.f / KVL) + EPS); const float* gk = kvn_g + l * KVL + lane * 4;
                  u32x2 o; o.x = pk2(v[0] * r * gk[0], v[1] * r * gk[1]); o.y = pk2(v[2] * r * gk[2], v[3] * r * gk[3]);
                  *((u32x2*)(CKVN + (size_t)m * KVL) + lane) = o; }
                { const float xv = __builtin_bit_cast(float, (unsigned)PH(30)[lane] << 16); const float xo = shfl_xor_l(xv, 32, lane);
                  const f32x2 cs = ((const f32x2*)ROPE)[(size_t)m * 32 + (lane & 31)];
                  const float y = (lane < 32) ? (xv * cs.x - xo * cs.y) : (xv * cs.x + xo * cs.y);
                  KROPE[(size_t)m * 64 + lane] = (bf16_t)f2bf(y); }
#undef PH
            }
            SEAM(pb + 2);
        }
        if (IN(pb + 3)) {
            PHASE_IDS();
            { pg8::Gemm g{WSP(bf16_t, WS_CQN), WSP(bf16_t, WS_WUQ) + (size_t)l * NQM * QL, MTOK, NQM, QL}; pg8::StaticOrder S; S.init(MTOK, NQM, G, bx);
              pg8::EpiBf16<0> E{WSP(bf16_t, WS_QM), NQM}; pg8::gemm_phase<pg8::EpiBf16<0>, pg8::StaticOrder, true, true>(ldsl, g, S, E, tid); }
            { pg8::Gemm g{WSP(bf16_t, WS_CKVN), WSP(bf16_t, WS_WUKV) + (size_t)l * NKV * KVL, MTOK, NKV, KVL}; pg8::StaticOrder S; S.init(MTOK, NKV, G, bx);
              pg8::EpiBf16<0, true> E{WSP(bf16_t, WS_KV), NKV / 128}; pg8::gemm_phase<pg8::EpiBf16<0, true>, pg8::StaticOrder, true, true>(ldsl, g, S, E, tid); }
            SEAM(pb + 3);
        }
        if (IN(pb + 4)) {
            for (int rep = 0; rep < ((PROBE_DUP & 1) ? 2 : 1); ++rep)
            for (int t = vcu; t < 16 * 64; t += G) {
                PHASE_IDS();
                const int mg = t >> 6, qb = t & 63, b = mg >> 3, h = mg & 7; const size_t r0 = (size_t)b * SEQ;
                const bf16_t* QM = WSP(bf16_t, WS_QM); const bf16_t* KV = WSP(bf16_t, WS_KV);
                att::attn_unit_dma<192, 128, false>(QM + (r0 + qb * 256) * NQM + h * 192, NQM, KV + (size_t)(b * 16 + 2 * h) * SEQ * 128, 128, WSP(bf16_t, WS_KROPE) + r0 * 64, KV + (size_t)(b * 16 + 2 * h + 1) * SEQ * 128, 128,
                                           WSP(bf16_t, WS_HB) + (r0 + qb * 256) * DM + 1024 + h * 128, DM, WSP(float, WS_ROPE) + (r0 + qb * 256) * 64, nullptr, nullptr, 0, nullptr,
                                           0.07216878364870323f * LOG2E, SEQ, (char*)lds, ldsl, tid);
            }
            for (int t = vcu; t < 8 * 64; t += G) {
                const int dgp = t >> 6, qb = t & 63, b = dgp >> 2, h = dgp & 3; const size_t r0 = (size_t)b * SEQ;
                { PHASE_IDS();
                  const bf16_t* PROJ = WSP(bf16_t, WS_PROJ);
                  att::attn_unit_dma<128, 256, true>(PROJ + ((size_t)(b * 32 + h * 2 + 0) * SEQ + qb * 256) * 128, 128, PROJ + (size_t)(b * 32 + 8 + h * 2 + 0) * SEQ * 128, 128, nullptr,
                                          PROJ + (size_t)(b * 32 + 16 + h * 2) * SEQ * 128, 128, WSP(bf16_t, WS_ODIFF) + (r0 + qb * 256) * 2048 + h * 256, 2048,
                                          nullptr, (const int*)ka->in[2] + r0, WSP(int, CTL_PMM) + (r0 >> 5) * 2, qb * 256, WSP(float, CTL_LUT) + h * 257, 0.08838834764831845f * LOG2E, SEQ, (char*)lds, ldsl, tid); }
                { PHASE_IDS();
                  const bf16_t* PROJ = WSP(bf16_t, WS_PROJ); const float* LAM = WSP(float, CTL_LAM);
                  const att::FuseArgs fa{WSP(bf16_t, WS_ODIFF) + (r0 + qb * 256) * 2048 + h * 256, WSP(bf16_t, WS_HB) + (r0 + qb * 256) * DM + h * 256, IN_F(11) + l * 256, LAM[l], LAM[2 + l]};
                  att::attn_unit_dma<128, 256, true, true>(PROJ + ((size_t)(b * 32 + h * 2 + 1) * SEQ + qb * 256) * 128, 128, PROJ + (size_t)(b * 32 + 8 + h * 2 + 1) * SEQ * 128, 128, nullptr,
                                          PROJ + (size_t)(b * 32 + 16 + h * 2) * SEQ * 128, 128, nullptr, 2048,
                                          nullptr, (const int*)ka->in[2] + r0, WSP(int, CTL_PMM) + (r0 >> 5) * 2, qb * 256, WSP(float, CTL_LUT) + h * 257, 0.08838834764831845f * LOG2E, SEQ, (char*)lds, ldsl, tid, fa); }
            }
            SEAM(pb + 4);
        }
        if (IN(pb + 6)) {
            PHASE_IDS();
            pg8::Gemm g{WSP(bf16_t, WS_HB), WSP(bf16_t, WS_WO) + (size_t)l * DM * DM, MTOK, DM, DM}; pg8::StaticOrder S; S.init(MTOK, DM, G, bx);
            pg8::EpiRes E{(l == 0) ? IN_F(0) : out, out, WSP(float, CTL_MOD) + (size_t)l * 2 * MODW + 2 * DM, MODW, DM};
            pg8::gemm_phase<pg8::EpiRes, pg8::StaticOrder, true, true>(ldsl, g, S, E, tid);
            SEAM(pb + 6);
        }
        if (IN(pb + 7)) { PHASE_IDS(); norm_mod_rows(out, WSP(float, CTL_MOD) + (size_t)l * 2 * MODW, 3 * DM, 4 * DM, WSP(bf16_t, WS_HB), gw, NGW, lane); SEAM(pb + 7); }
        if (IN(pb + 8)) {
            PHASE_IDS();
            pg8::Gemm g{WSP(bf16_t, WS_HB), WSP(bf16_t, WS_W1) + (size_t)l * DFF * DM, MTOK, DFF, DM}; pg8::StaticOrder S; S.init(MTOK, DFF, G, bx);
            pg8::EpiBf16<2> E{WSP(bf16_t, WS_U), DFF};
            for (int rep = 0; rep < ((PROBE_DUP & 4) ? 2 : 1); ++rep)
            pg8::gemm_phase<pg8::EpiBf16<2>, pg8::StaticOrder, true, true>(ldsl, g, S, E, tid);
            SEAM(pb + 8);
        }
        if (IN(pb + 9)) {
            PHASE_IDS();
            pg8::Gemm g{WSP(bf16_t, WS_U), WSP(bf16_t, WS_W2) + (size_t)l * DM * DFF, MTOK, DM, DFF}; pg8::StaticOrder S; S.init(MTOK, DM, G, bx);
            pg8::EpiRes E{out, out, WSP(float, CTL_MOD) + (size_t)l * 2 * MODW + 5 * DM, MODW, DM};
            pg8::gemm_phase<pg8::EpiRes, pg8::StaticOrder, true, true>(ldsl, g, S, E, tid);
            SEAM(pb + 9);
        }
    }
    if (IN(21)) {
        PHASE_IDS();
        const float* fin_g = IN_F(19);
        for (int m = gw; m < MTOK; m += NGW) {
            f32x4* xr = (f32x4*)(out + (size_t)m * DM) + lane; f32x4 v[8]; float s = 0.f;
#pragma unroll
            for (int j = 0; j < 8; ++j) { v[j] = xr[64 * j]; s += (v[j].x * v[j].x + v[j].y * v[j].y) + (v[j].z * v[j].z + v[j].w * v[j].w); }
            const float r = rsqrtf(wave_sum(s, lane) * (1.f / DM) + EPS);
#pragma unroll
            for (int j = 0; j < 8; ++j) { const f32x4 gg = *((const f32x4*)fin_g + lane + 64 * j); xr[64 * j] = (v[j] * r) * gg; }
        }
    }
#undef IN
#undef SEAM
}

extern "C" void kernel_launch(void* const* d_in, const int* in_sizes, int n_in, void* d_out, int out_size, void* d_ws, size_t ws_size, hipStream_t stream) {
    static int grid = 0;
    if (grid == 0) {
        if (n_in != 20 || out_size != MTOK * DM || ws_size < WS_END) { fprintf(stderr, "kernel_launch: unexpected shapes (n_in %d out %d ws %zu, need ws >= %zu)\n", n_in, out_size, ws_size, (size_t)WS_END); }
        int dev = 0, cus = 0, per_cu = 0;
        (void)hipGetDevice(&dev); (void)hipDeviceGetAttribute(&cus, hipDeviceAttributeMultiprocessorCount, dev);
        if (hipFuncSetAttribute((const void*)mk_fwd, hipFuncAttributeMaxDynamicSharedMemorySize, LDS_BYTES) != hipSuccess) fprintf(stderr, "kernel_launch: hipFuncSetAttribute failed\n");
        if (hipOccupancyMaxActiveBlocksPerMultiprocessor(&per_cu, (const void*)mk_fwd, 512, LDS_BYTES) != hipSuccess || per_cu < 1) { fprintf(stderr, "kernel_launch: occupancy query says %d\n", per_cu); per_cu = 1; }
        (void)hipGetLastError();
        grid = cus > 0 ? cus : 256;
    }
    Args a{};
    for (int i = 0; i < 20; ++i) a.in[i] = d_in[i];
    a.out = (float*)d_out; a.ws = (unsigned char*)d_ws;
#if MK_N_LAUNCHES == 1
    a.ph_lo = 0; a.ph_hi = N_PHASES; a.coop = 1;
    void* kargs[] = {&a};
    hipError_t e = hipLaunchCooperativeKernel((const void*)mk_fwd, dim3(grid), dim3(512), kargs, LDS_BYTES, stream);
    if (e != hipSuccess) fprintf(stderr, "kernel_launch: cooperative launch failed: %s (grid %d)\n", hipGetErrorString(e), grid);
#else
    for (int p = 0; p < N_PHASES; ++p) {
        a.ph_lo = p; a.ph_hi = p + 1; a.coop = 0;
        hipLaunchKernelGGL(mk_fwd, dim3(grid), dim3(512), LDS_BYTES, stream, a);
    }
    const hipError_t le = hipPeekAtLastError();
    if (le != hipSuccess) fprintf(stderr, "kernel_launch: launch failed: %s\n", hipGetErrorName(le));
#endif
}
```

```cpp
#include <hip/hip_runtime.h>
#include <hip/hip_cooperative_groups.h>
#include <cstdio>
#include <cstdint>
namespace cg = cooperative_groups;

#ifndef PROBE_DUP
#define PROBE_DUP 0
#endif
#ifndef PP_STAGGER
#define PP_STAGGER 0
#endif
#ifndef MK_N_LAUNCHES
#define MK_N_LAUNCHES 1
#endif

namespace pg8 {
#define PG8_LAS __attribute__((address_space(3)))
typedef unsigned short bf16_t;
typedef short bf16x8 __attribute__((ext_vector_type(8)));
typedef float f32x4 __attribute__((ext_vector_type(4)));
typedef unsigned u32x4 __attribute__((ext_vector_type(4)));
constexpr int BM = 256, BK = 64, HALF = 128, HTB = HALF * BK * 2, STAGE_BYTES = 8 * HTB, NXCD = 8, WGM = 8;

__host__ __device__ __forceinline__ int lds_byte(int r, int c) { const int st = (r >> 4) * 2 + (c >> 5), rr = r & 15, cc = c & 31, ob = rr * 64 + cc * 2; return st * 1024 + (ob ^ (((ob >> 9) & 1) << 5)); }
__host__ __device__ __forceinline__ void stage_rc(int b, int& R, int& C) { const int st = b / 1024, sb = b % 1024, swz = sb ^ (((sb >> 9) & 1) << 5); R = (st >> 1) * 16 + swz / 64; C = (st & 1) * 32 + (swz % 64) / 2; }
__host__ __device__ __forceinline__ int perm32(int rho) { const int n = rho >> 4, i = rho & 15; return 8 * (i >> 2) + 4 * n + (i & 3); }

struct Unit { int pm, pn; };
struct Gemm { const bf16_t* A; const bf16_t* Bt; int M, N, K; };

struct StaticOrder {
    int nM, nN, nwg, G, c;
    __host__ __device__ void init(int M, int N, int G_, int c_) { nM = M / BM; nN = N / BM; nwg = nM * nN; G = G_; c = c_; }
    __host__ __device__ bool next(int i, Unit& u) const {
        const long L = (long)i * G + c; if (L >= nwg) return false;
        int wgid = (int)L; { const int q = nwg / NXCD, r = nwg % NXCD, xcd = wgid % NXCD, off = wgid / NXCD; wgid = (xcd < r ? xcd * (q + 1) : r * (q + 1) + (xcd - r) * q) + off; }
        const int nig = WGM * nN, gid = wgid / nig, fm = gid * WGM, gsz = (nM - fm) < WGM ? (nM - fm) : WGM;
        u.pm = fm + ((wgid % nig) % gsz); u.pn = (wgid % nig) / gsz; return true;
    }
    __device__ __forceinline__ void a_ready(const Unit&) const {}
    __device__ __forceinline__ void done(const Unit&) const {}
};

__device__ __forceinline__ unsigned cvt_pk_bf16(float lo, float hi) { unsigned r; asm volatile("v_cvt_pk_bf16_f32 %0, %1, %2" : "=v"(r) : "v"(lo), "v"(hi)); return r; }

template <int ACT  , bool HM = false  > struct EpiBf16 {
    static constexpr bool PERM = true, AFTER_DRAIN = false;
    bf16_t* O; int ldc;
    __device__ __forceinline__ void operator()(const f32x4 (&acc)[2][2][4][2], const Unit& u, int wr, int wc, int fr, int fq) const {
        const int row0 = u.pm * BM + wr * 64 + fr; const int col0 = u.pn * BM + wc * 32 + 8 * fq;
#pragma unroll
        for (int ai = 0; ai < 2; ++ai)
#pragma unroll
            for (int m = 0; m < 4; ++m) { const int row = row0 + ai * HALF + m * 16;
                bf16_t* rowp = HM ? O + ((size_t)((row >> 14) * ldc + u.pn * 2) * 16384 + (row & 16383)) * 128 + wc * 32 + 8 * fq : O + (size_t)row * ldc + col0;
#pragma unroll
                for (int bj = 0; bj < 2; ++bj) { f32x4 v0 = acc[ai][bj][m][0], v1 = acc[ai][bj][m][1];
                    if (ACT == 2) {
#pragma unroll
                        for (int e = 0; e < 4; ++e) { const float a = fmaxf(v0[e], 0.f), b = fmaxf(v1[e], 0.f); v0[e] = a * a; v1[e] = b * b; } }
                    u32x4 w; w.x = cvt_pk_bf16(v0[0], v0[1]); w.y = cvt_pk_bf16(v0[2], v0[3]); w.z = cvt_pk_bf16(v1[0], v1[1]); w.w = cvt_pk_bf16(v1[2], v1[3]);
                    *(u32x4*)(rowp + (HM ? (size_t)bj * 16384 * 128 : (size_t)bj * HALF)) = w; } }
    }
};
struct EpiRes {
    static constexpr bool PERM = true, AFTER_DRAIN = false;
    const float* base; float* out; const float* gate; int gstride; int ldc;
    __device__ __forceinline__ void operator()(const f32x4 (&acc)[2][2][4][2], const Unit& u, int wr, int wc, int fr, int fq) const {
        const int col0 = u.pn * BM + wc * 32 + 8 * fq; const float* g = gate + (size_t)(u.pm >> 6) * gstride + col0;
        f32x4 gv[2][2];
#pragma unroll
        for (int bj = 0; bj < 2; ++bj)
#pragma unroll
            for (int n = 0; n < 2; ++n) gv[bj][n] = *(const f32x4*)(g + bj * HALF + n * 4);
#pragma unroll
        for (int ai = 0; ai < 2; ++ai)
#pragma unroll
            for (int m = 0; m < 4; ++m) { const size_t off = (size_t)(u.pm * BM + ai * HALF + wr * 64 + m * 16 + fr) * ldc + col0;
#pragma unroll
                for (int bj = 0; bj < 2; ++bj)
#pragma unroll
                    for (int n = 0; n < 2; ++n) { const f32x4 bs = *(const f32x4*)(base + off + bj * HALF + n * 4);
                        *(f32x4*)(out + off + bj * HALF + n * 4) = bs + gv[bj][n] * acc[ai][bj][m][n]; }
                if (m & 1) asm volatile("" ::: "memory"); }
    }
};

__device__ __forceinline__ void pg8_glds_s(const void* sbase, unsigned voff, unsigned ldsaddr) {
    unsigned keep;
    asm volatile("s_mov_b32 %0, m0\n\ts_mov_b32 m0, %3\n\ts_nop 0\n\tglobal_load_lds_dwordx4 %1, %2\n\ts_mov_b32 m0, %0" : "=&s"(keep) : "v"(voff), "s"(sbase), "s"(ldsaddr) : "memory");
}
template <class Epi, class Sched, bool ALIGN_EPI = false, bool SP2 = false>
__device__ __forceinline__ void gemm_phase(PG8_LAS unsigned char* lds, const Gemm g, const Sched& S, const Epi& E, const int tid) {
    const int wid = __builtin_amdgcn_readfirstlane(tid >> 6), lane = tid & 63, wr = wid >> 2, wc = wid & 3, fr = lane & 15, fq = lane >> 4;
    const int K = g.K, nt = K / BK;
    unsigned voffA[2], voffB[2];
#pragma unroll
    for (int i = 0; i < 2; ++i) { int R, C; stage_rc(tid * 16 + i * 8192, R, C); const int Rb = Epi::PERM ? ((R & ~31) + perm32(R & 31)) : R;
        voffA[i] = (unsigned)(R * K + C) * 2u; voffB[i] = (unsigned)(Rb * K + C) * 2u; }
    const size_t kstep = (size_t)(BK * 2);
    const size_t hstep = (size_t)HALF * K * 2;
    const size_t tstep = 2 * hstep;
    const unsigned ldsw = (unsigned)wid * 1024u, ldsb0 = (unsigned)(uintptr_t)lds;
    const int aoff = lds_byte(wr * 64 + fr, fq * 8), boff = lds_byte(wc * 32 + fr, fq * 8);
#define PG8_SA(b, h) (((b) * 2 + (h)) * HTB)
#define PG8_SB(b, h) ((4 + (b) * 2 + (h)) * HTB)
#define PG8_STAGE(bufoff, gbase, voff) do { _Pragma("unroll") for (int _i = 0; _i < 2; ++_i) \
        pg8_glds_s((const void*)(gbase), (voff)[_i], ldsb0 + (unsigned)(bufoff) + ldsw + _i * 8192u); } while (0)
#define PG8_LDA(dst, b, h) do { _Pragma("unroll") for (int m = 0; m < 4; ++m) _Pragma("unroll") for (int k = 0; k < 2; ++k) dst[m][k] = *(const PG8_LAS bf16x8*)(lds + PG8_SA(b, h) + aoff + m * 2048 + k * 1024); } while (0)
#define PG8_LDB(dst, b, h) do { _Pragma("unroll") for (int n = 0; n < 2; ++n) _Pragma("unroll") for (int k = 0; k < 2; ++k) dst[n][k] = *(const PG8_LAS bf16x8*)(lds + PG8_SB(b, h) + boff + n * 2048 + k * 1024); } while (0)
#define PG8_MMA(ai, bj, At, Bt) do { __builtin_amdgcn_s_setprio(1); _Pragma("unroll") for (int m = 0; m < 4; ++m) _Pragma("unroll") for (int n = 0; n < 2; ++n) _Pragma("unroll") for (int k = 0; k < 2; ++k) \
        acc[ai][bj][m][n] = __builtin_amdgcn_mfma_f32_16x16x32_bf16(Bt[n][k], At[m][k], acc[ai][bj][m][n], 0, 0, 0); __builtin_amdgcn_s_setprio(0); } while (0)
#define PG8_WAIT_V(n) asm volatile("s_waitcnt vmcnt(" #n ")" ::: "memory")
#define PG8_WAIT_L(n) asm volatile("s_waitcnt lgkmcnt(" #n ")" ::: "memory")
#define PG8_BAR __builtin_amdgcn_s_barrier()
#define PG8_SCHED __builtin_amdgcn_sched_barrier(0)
    Unit cur, nxt; int ui = 0;
    if (!S.next(0, cur)) return;
    f32x4 acc[2][2][4][2];
#pragma unroll
    for (int a = 0; a < 2; ++a)
#pragma unroll
        for (int b = 0; b < 2; ++b)
#pragma unroll
            for (int m = 0; m < 4; ++m)
#pragma unroll
                for (int n = 0; n < 2; ++n) acc[a][b][m][n] = (f32x4){0.f, 0.f, 0.f, 0.f};
    bf16x8 At[4][2], B0[2][2], B1[2][2];
    const char* cA = (const char*)g.A + (size_t)cur.pm * tstep; const char* cB = (const char*)g.Bt + (size_t)cur.pn * tstep;
    S.a_ready(cur);
    if constexpr (SP2) {
        PG8_STAGE(PG8_SB(0, 0), cB, voffB); PG8_STAGE(PG8_SB(0, 1), cB + hstep, voffB); PG8_STAGE(PG8_SA(0, 0), cA, voffA); PG8_STAGE(PG8_SA(0, 1), cA + hstep, voffA);
        if (wr == 1) PG8_BAR;
        PG8_WAIT_V(2); PG8_BAR;
        PG8_STAGE(PG8_SB(1, 0), cB + kstep, voffB); PG8_STAGE(PG8_SA(1, 0), cA + kstep, voffA); PG8_STAGE(PG8_SB(1, 1), cB + hstep + kstep, voffB);
        PG8_WAIT_V(6); PG8_BAR;
    } else {
        PG8_STAGE(PG8_SB(0, 0), cB, voffB); PG8_STAGE(PG8_SA(0, 0), cA, voffA); PG8_STAGE(PG8_SB(0, 1), cB + hstep, voffB); PG8_STAGE(PG8_SA(0, 1), cA + hstep, voffA);
        if (wr == 1) PG8_BAR;
        PG8_WAIT_V(4); PG8_BAR;
        PG8_STAGE(PG8_SB(1, 0), cB + kstep, voffB); PG8_STAGE(PG8_SA(1, 0), cA + kstep, voffA); PG8_STAGE(PG8_SB(1, 1), cB + hstep + kstep, voffB);
        PG8_WAIT_V(6); PG8_BAR;
    }
    for (;;) {
        const bool has_next = S.next(ui + 1, nxt);
        const char* nA = has_next ? (const char*)g.A + (size_t)nxt.pm * tstep : cA; const char* nB = has_next ? (const char*)g.Bt + (size_t)nxt.pn * tstep : cB;
        for (int t = 0; t < nt; t += 2) {
            const bool last = (t == nt - 2);
            const char* a1 = cA + (size_t)(t + 1) * kstep;
            const char* a2 = last ? nA : cA + (size_t)(t + 2) * kstep; const char* b2 = last ? nB : cB + (size_t)(t + 2) * kstep;
            const char* a3 = a2 + kstep; const char* b3 = b2 + kstep;
            if (last && has_next) S.a_ready(nxt);
            if constexpr (SP2) {
            PG8_LDB(B0, 0, 0); PG8_LDB(B1, 0, 1); PG8_SCHED; PG8_LDA(At, 0, 0); PG8_STAGE(PG8_SA(1, 1), a1 + hstep, voffA);
            PG8_WAIT_V(8); PG8_WAIT_L(0); PG8_BAR; PG8_MMA(0, 0, At, B0); PG8_MMA(0, 1, At, B1); PG8_BAR; PG8_SCHED;
            PG8_LDA(At, 0, 1); PG8_STAGE(PG8_SB(0, 0), b2, voffB); PG8_STAGE(PG8_SB(0, 1), b2 + hstep, voffB); PG8_STAGE(PG8_SA(0, 0), a2, voffA);
            PG8_WAIT_V(8); PG8_WAIT_L(0); PG8_BAR; PG8_MMA(1, 0, At, B0); PG8_MMA(1, 1, At, B1); PG8_BAR; PG8_SCHED;
            PG8_LDB(B0, 1, 0); PG8_LDB(B1, 1, 1); PG8_SCHED; PG8_LDA(At, 1, 0); PG8_STAGE(PG8_SA(0, 1), a2 + hstep, voffA);
            PG8_WAIT_V(8); PG8_WAIT_L(0); PG8_BAR; PG8_MMA(0, 0, At, B0); PG8_MMA(0, 1, At, B1); PG8_BAR; PG8_SCHED;
            PG8_LDA(At, 1, 1); PG8_STAGE(PG8_SB(1, 0), b3, voffB); PG8_STAGE(PG8_SB(1, 1), b3 + hstep, voffB); PG8_STAGE(PG8_SA(1, 0), a3, voffA);
            PG8_WAIT_V(8); PG8_WAIT_L(0); PG8_BAR; PG8_MMA(1, 0, At, B0); PG8_MMA(1, 1, At, B1); PG8_BAR; PG8_SCHED;
            } else {
            PG8_LDB(B0, 0, 0); PG8_SCHED; PG8_LDA(At, 0, 0); PG8_STAGE(PG8_SA(1, 1), a1 + hstep, voffA);
            PG8_WAIT_L(8); PG8_BAR; PG8_WAIT_L(0); PG8_MMA(0, 0, At, B0); PG8_BAR; PG8_SCHED;
            PG8_LDB(B1, 0, 1); PG8_STAGE(PG8_SB(0, 0), b2, voffB);
            PG8_BAR; PG8_WAIT_L(0); PG8_MMA(0, 1, At, B1); PG8_BAR;
            PG8_LDA(At, 0, 1); PG8_STAGE(PG8_SA(0, 0), a2, voffA);
            PG8_BAR; PG8_WAIT_L(0); PG8_MMA(1, 0, At, B0); PG8_BAR; PG8_SCHED;
            PG8_STAGE(PG8_SB(0, 1), b2 + hstep, voffB);
            PG8_WAIT_V(6); PG8_BAR; PG8_MMA(1, 1, At, B1); PG8_BAR;
            PG8_LDB(B0, 1, 0); PG8_SCHED; PG8_LDA(At, 1, 0); PG8_STAGE(PG8_SA(0, 1), a2 + hstep, voffA);
            PG8_WAIT_L(8); PG8_BAR; PG8_WAIT_L(0); PG8_MMA(0, 0, At, B0); PG8_BAR; PG8_SCHED;
            PG8_LDB(B1, 1, 1); PG8_STAGE(PG8_SB(1, 0), b3, voffB);
            PG8_BAR; PG8_WAIT_L(0); PG8_MMA(0, 1, At, B1); PG8_BAR;
            PG8_LDA(At, 1, 1); PG8_STAGE(PG8_SA(1, 0), a3, voffA);
            PG8_BAR; PG8_WAIT_L(0); PG8_MMA(1, 0, At, B0); PG8_BAR; PG8_SCHED;
            PG8_STAGE(PG8_SB(1, 1), b3 + hstep, voffB);
            PG8_WAIT_V(6); PG8_BAR; PG8_MMA(1, 1, At, B1); PG8_BAR;
            }
        }
        if constexpr (ALIGN_EPI) { if (wr == 0) PG8_BAR; }
        if constexpr (!Epi::AFTER_DRAIN) { E(acc, cur, wr, wc, fr, fq); S.done(cur); }
        if (!has_next) break;
#pragma unroll
        for (int a = 0; a < 2; ++a)
#pragma unroll
            for (int b = 0; b < 2; ++b)
#pragma unroll
                for (int m = 0; m < 4; ++m)
#pragma unroll
                    for (int n = 0; n < 2; ++n) acc[a][b][m][n] = (f32x4){0.f, 0.f, 0.f, 0.f};
        cur = nxt; cA = nA; cB = nB; ++ui;
        if constexpr (ALIGN_EPI) { if (wr == 1) PG8_BAR; }
    }
    PG8_WAIT_V(0);
    if constexpr (!ALIGN_EPI) { if (wr == 0) PG8_BAR; }
    PG8_BAR;
#undef PG8_SA
#undef PG8_SB
#undef PG8_STAGE
#undef PG8_LDA
#undef PG8_LDB
#undef PG8_MMA
#undef PG8_WAIT_V
#undef PG8_WAIT_L
#undef PG8_BAR
#undef PG8_SCHED
}
}

typedef unsigned short bf16_t;
constexpr int BATCH = 2, SEQ = 16384, DM = 2048, MTOK = BATCH * SEQ, DEPTH = 2;
constexpr int IN_COLS = 3904, IN_PAD = 4096, DFF = 8192, QL = 512, KVL = 256, NQM = 1536, NKV = 2048, MODW = 6 * DM;
constexpr int OFF_DQ = 0, OFF_DK = 1024, OFF_DV = 2048, OFF_CQ = 3072, OFF_CKV = 3584, OFF_KR = 3840;
constexpr float EPS = 1e-6f, LOG2E = 1.4426950408889634f;

constexpr size_t MiB = 1u << 20;
constexpr size_t WS_CTL = 0;
constexpr size_t CTL_MOD = 0;
constexpr size_t CTL_LUT = 256 * 1024;
constexpr size_t CTL_LAM = CTL_LUT + 8192;
constexpr size_t CTL_PMM = CTL_LAM + 256;
constexpr size_t WS_ROPE = 2 * MiB;
constexpr size_t WS_WIN = 10 * MiB;
constexpr size_t WS_WUQ = 42 * MiB;
constexpr size_t WS_WUKV = 45 * MiB;
constexpr size_t WS_WO = 47 * MiB;
constexpr size_t WS_W1 = 63 * MiB;
constexpr size_t WS_W2 = 127 * MiB;
constexpr size_t WS_CKVN = 191 * MiB;
constexpr size_t WS_KROPE = 207 * MiB;
constexpr size_t WS_HB = 211 * MiB;
constexpr size_t WS_ODIFF = 339 * MiB;
constexpr size_t WS_U = 467 * MiB;
constexpr size_t WS_PROJ = WS_U;
constexpr size_t WS_QM = WS_U + 256 * MiB;
constexpr size_t WS_KV = WS_U + 352 * MiB;
constexpr size_t WS_CQN = WS_U + 480 * MiB;
constexpr size_t WS_END = WS_U + 512 * MiB;

#define LAS __attribute__((address_space(3)))
typedef float f32x4 __attribute__((ext_vector_type(4)));
typedef float f32x2 __attribute__((ext_vector_type(2)));
typedef unsigned u32x4 __attribute__((ext_vector_type(4)));
typedef unsigned u32x2 __attribute__((ext_vector_type(2)));
typedef int i32x4 __attribute__((ext_vector_type(4)));
__device__ __forceinline__ unsigned f2bf(float f) { unsigned u = __builtin_bit_cast(unsigned, f); return (u + 0x7fffu + ((u >> 16) & 1u)) >> 16; }
__device__ __forceinline__ unsigned pk2(float lo, float hi) { return f2bf(lo) | (f2bf(hi) << 16); }
__device__ __forceinline__ float bf_lo(unsigned w) { return __builtin_bit_cast(float, w << 16); }
__device__ __forceinline__ float bf_hi(unsigned w) { return __builtin_bit_cast(float, w & 0xffff0000u); }
__device__ __forceinline__ float shfl_xor_l(float v, int o, int lane) { return __builtin_bit_cast(float, __builtin_amdgcn_ds_bpermute((lane ^ o) << 2, __builtin_bit_cast(int, v))); }
__device__ __forceinline__ float wave_sum(float v, int lane) {
#pragma unroll
    for (int o = 1; o < 64; o <<= 1) v += shfl_xor_l(v, o, lane);
    return v;
}
__device__ const float INV_FREQ[32] = {1.000000000e+00f, 7.498942018e-01f, 5.623413324e-01f, 4.216965139e-01f, 3.162277639e-01f, 2.371373922e-01f, 1.778279394e-01f, 1.333521456e-01f,
    1.000000015e-01f, 7.498941571e-02f, 5.623412877e-02f, 4.216964915e-02f, 3.162277862e-02f, 2.371373586e-02f, 1.778279431e-02f, 1.333521493e-02f,
    9.999999776e-03f, 7.498942316e-03f, 5.623413250e-03f, 4.216964822e-03f, 3.162277862e-03f, 2.371373819e-03f, 1.778279431e-03f, 1.333521446e-03f,
    1.000000047e-03f, 7.498941850e-04f, 5.623413017e-04f, 4.216965463e-04f, 3.162277862e-04f, 2.371373848e-04f, 1.778279402e-04f, 1.333521504e-04f};

namespace att {
using bf16x8 = __attribute__((ext_vector_type(8))) short;
using s16x4 = __attribute__((ext_vector_type(4))) short;
using f32x16 = __attribute__((ext_vector_type(16))) float;
constexpr int NW = 8, QBLK = 32, KVBLK = 64;
constexpr int KP = 272, K2P = 144;
constexpr int SHM_V = 16384, SHM_K = 64 * KP, SHM_K2 = 64 * K2P;
constexpr int OFF_V = 0, OFF_K = 2 * SHM_V, OFF_K2 = OFF_K + 2 * SHM_K, OFF_WS = OFF_K2 + 2 * SHM_K2, OFF_LUT = OFF_WS + NW * 256, OFF_QR = OFF_LUT + 2048, QRB = 32 * KP, ATT_LDS = OFF_QR + NW * QRB;
constexpr float THR2 = 8.f * 1.4426950408889634f;
#define SBAR() __builtin_amdgcn_sched_barrier(0)
__device__ __forceinline__ int crow(int r, int hi) { return (r & 3) + 8 * (r >> 2) + 4 * hi; }
__device__ __forceinline__ unsigned cvtpk(float lo, float hi) { unsigned r; asm volatile("v_cvt_pk_bf16_f32 %0, %1, %2" : "=v"(r) : "v"(lo), "v"(hi)); return r; }
__device__ __forceinline__ int kswz(int row, int colB) { return row * KP + colB; }
__device__ __forceinline__ int k2swz(int row, int colB) { return row * K2P + colB; }
__device__ __forceinline__ int v_st(int k, int c) { const int kk = (k & ~0xC) | ((k & 4) << 1) | ((k & 8) >> 1); return ((kk >> 3) * 4 + (c >> 5)) * 512 + ((kk & 7) * 32 + (c & 31)) * 2; }
__device__ __forceinline__ int v_rd_base(int lane) { return ((lane & 3) << 3) | (((lane >> 2) & 3) << 6) | (((lane >> 4) & 1) << 5) | (((lane >> 5) & 1) << 8); }
constexpr int v_rd_off(int d0, int ks, int half) { return d0 * 512 + ks * 4096 + half * 2048; }
template <int OFF> __device__ __forceinline__ s16x4 tr_read(int vb) { s16x4 r; asm volatile("ds_read_b64_tr_b16 %0, %1 offset:%2" : "=&v"(r) : "v"(vb), "i"(OFF) : "memory"); return r; }
template <int D0> __device__ __forceinline__ void pv_one(f32x16& od, int vb, bf16x8 pa0, bf16x8 pa1, bf16x8 pa2, bf16x8 pa3) {
    const s16x4 l0 = tr_read<v_rd_off(D0, 0, 0)>(vb), h0 = tr_read<v_rd_off(D0, 0, 1)>(vb), l1 = tr_read<v_rd_off(D0, 1, 0)>(vb), h1 = tr_read<v_rd_off(D0, 1, 1)>(vb);
    const s16x4 l2 = tr_read<v_rd_off(D0, 2, 0)>(vb), h2 = tr_read<v_rd_off(D0, 2, 1)>(vb), l3 = tr_read<v_rd_off(D0, 3, 0)>(vb), h3 = tr_read<v_rd_off(D0, 3, 1)>(vb);
    asm volatile("s_waitcnt lgkmcnt(0)" ::: "memory"); SBAR();
#define PK(L, H) (bf16x8){L[0], L[1], L[2], L[3], H[0], H[1], H[2], H[3]}
    od = __builtin_amdgcn_mfma_f32_32x32x16_bf16(pa0, PK(l0, h0), od, 0, 0, 0);
    od = __builtin_amdgcn_mfma_f32_32x32x16_bf16(pa1, PK(l1, h1), od, 0, 0, 0);
    od = __builtin_amdgcn_mfma_f32_32x32x16_bf16(pa2, PK(l2, h2), od, 0, 0, 0);
    od = __builtin_amdgcn_mfma_f32_32x32x16_bf16(pa3, PK(l3, h3), od, 0, 0, 0);
#undef PK
}
__device__ __forceinline__ void pv_d0(f32x16* o, int vb, bf16x8 pa0, bf16x8 pa1, bf16x8 pa2, bf16x8 pa3) {
    pv_one<0>(o[0], vb, pa0, pa1, pa2, pa3); pv_one<1>(o[1], vb, pa0, pa1, pa2, pa3); pv_one<2>(o[2], vb, pa0, pa1, pa2, pa3); pv_one<3>(o[3], vb, pa0, pa1, pa2, pa3);
}
template <int DQK, bool QL> __device__ __forceinline__ void qkt_r(f32x16& p0, f32x16& p1, const char* Ks, const char* K2s, const bf16x8* qr, const char* qrl, int r32, int hi) {
    p0 = f32x16{}; p1 = f32x16{};
#pragma unroll
    for (int d0 = 0; d0 < 8; ++d0) { const int cb = (d0 * 16 + hi * 8) * 2;
        const bf16x8 b0 = *reinterpret_cast<const bf16x8*>(Ks + kswz(r32, cb));
        const bf16x8 b1 = *reinterpret_cast<const bf16x8*>(Ks + kswz(32 + r32, cb));
        bf16x8 qv;
        if (QL && d0 >= 4) qv = *reinterpret_cast<const bf16x8*>(qrl + k2swz(r32, ((d0 - 4) * 16 + hi * 8) * 2)); else qv = qr[d0];
        p0 = __builtin_amdgcn_mfma_f32_32x32x16_bf16(b0, qv, p0, 0, 0, 0);
        p1 = __builtin_amdgcn_mfma_f32_32x32x16_bf16(b1, qv, p1, 0, 0, 0); }
    if constexpr (DQK == 192) {
#pragma unroll
        for (int d0 = 0; d0 < 4; ++d0) { const int cb = (d0 * 16 + hi * 8) * 2;
            const bf16x8 b0 = *reinterpret_cast<const bf16x8*>(K2s + k2swz(r32, cb));
            const bf16x8 b1 = *reinterpret_cast<const bf16x8*>(K2s + k2swz(32 + r32, cb));
            p0 = __builtin_amdgcn_mfma_f32_32x32x16_bf16(b0, qr[8 + d0], p0, 0, 0, 0);
            p1 = __builtin_amdgcn_mfma_f32_32x32x16_bf16(b1, qr[8 + d0], p1, 0, 0, 0); }
    }
}
template <int DQK> __device__ __forceinline__ void qkt(f32x16& p0, f32x16& p1, const char* Ks, const char* K2s, const bf16x8* qr, const char* qrl, int r32, int hi) {
    p0 = f32x16{}; p1 = f32x16{};
#pragma unroll
    for (int d0 = 0; d0 < 8; ++d0) { const int cb = (d0 * 16 + hi * 8) * 2;
        const bf16x8 b0 = *reinterpret_cast<const bf16x8*>(Ks + kswz(r32, cb));
        const bf16x8 b1 = *reinterpret_cast<const bf16x8*>(Ks + kswz(32 + r32, cb));
        bf16x8 qv;
        if (DQK == 192 && d0 >= 4) qv = *reinterpret_cast<const bf16x8*>(qrl + kswz(r32, 128 + ((d0 - 4) * 16 + hi * 8) * 2)); else qv = qr[d0];
        p0 = __builtin_amdgcn_mfma_f32_32x32x16_bf16(b0, qv, p0, 0, 0, 0);
        p1 = __builtin_amdgcn_mfma_f32_32x32x16_bf16(b1, qv, p1, 0, 0, 0); }
    if constexpr (DQK == 192) {
#pragma unroll
        for (int d0 = 0; d0 < 4; ++d0) { const int cb = (d0 * 16 + hi * 8) * 2;
            const bf16x8 b0 = *reinterpret_cast<const bf16x8*>(K2s + k2swz(r32, cb));
            const bf16x8 b1 = *reinterpret_cast<const bf16x8*>(K2s + k2swz(32 + r32, cb));
            const bf16x8 qv = *reinterpret_cast<const bf16x8*>(qrl + kswz(r32, cb));
            p0 = __builtin_amdgcn_mfma_f32_32x32x16_bf16(b0, qv, p0, 0, 0, 0);
            p1 = __builtin_amdgcn_mfma_f32_32x32x16_bf16(b1, qv, p1, 0, 0, 0); }
    }
}
template <bool BIAS, bool DEFER = false> __device__ __forceinline__ void partialSM(f32x16& p0, f32x16& p1, float& m_reg, float& alpha, float C, float tb2, bool slow,
                                                                const int* __restrict__ posk, int pq, const float* lut, int hi, float* cm_out = nullptr, float* off_out = nullptr, bool chk = true) {
    float cm = C, tb = BIAS ? tb2 : 0.f;
    if constexpr (BIAS) {
        if (slow) {
#pragma unroll
            for (int g = 0; g < 4; ++g) { const i32x4 ka = *(const i32x4*)(posk + 8 * g + 4 * hi), kb = *(const i32x4*)(posk + 32 + 8 * g + 4 * hi);
#pragma unroll
                for (int e = 0; e < 4; ++e) { int ia = ka[e] - pq; ia = ia < -128 ? -128 : (ia > 128 ? 128 : ia); int ib = kb[e] - pq; ib = ib < -128 ? -128 : (ib > 128 ? 128 : ib);
                    p0[4 * g + e] = fmaf(p0[4 * g + e], C, lut[ia + 128]); p1[4 * g + e] = fmaf(p1[4 * g + e], C, lut[ib + 128]); }
                asm volatile("" ::: "memory"); }
            cm = 1.f; tb = 0.f;
        }
    }
    float mn = m_reg; alpha = 1.f;
    if (chk) {
        float pmax = p0[0];
#pragma unroll
        for (int r = 1; r < 16; ++r) pmax = fmaxf(pmax, p0[r]);
#pragma unroll
        for (int r = 0; r < 16; ++r) pmax = fmaxf(pmax, p1[r]);
        { auto rr = __builtin_amdgcn_permlane32_swap(__float_as_uint(pmax), __float_as_uint(pmax), false, false);
          pmax = fmaxf(__uint_as_float(rr[0]), __uint_as_float(rr[1])); }
        const float tmax = fmaf(pmax, cm, tb);
        if (__builtin_expect(!__all(tmax - m_reg <= THR2), 0)) { mn = fmaxf(m_reg, tmax); alpha = __builtin_amdgcn_exp2f(m_reg - mn); m_reg = mn; }
    }
    const float off = tb - mn;
#pragma unroll
    for (int r = 0; r < 16; ++r) p0[r] = fmaf(p0[r], cm, off);
    if constexpr (DEFER) { *cm_out = cm; *off_out = off; }
    else {
#pragma unroll
        for (int r = 0; r < 16; ++r) p1[r] = fmaf(p1[r], cm, off); }
#pragma unroll
    for (int r = 0; r < 16; ++r) p0[r] = __builtin_amdgcn_exp2f(p0[r]);
}
template <bool BIAS> __device__ __forceinline__ void smFront(f32x16& p0, f32x16& p1, float& m_reg, float& alpha, bool slow, bool first,
                                                              const int* __restrict__ posk, int pq, const float* lut, int hi, bool chk = true) {
    if constexpr (BIAS) {
        if (slow) {
#pragma unroll
            for (int g = 0; g < 4; ++g) { const i32x4 ka = *(const i32x4*)(posk + 8 * g + 4 * hi), kb = *(const i32x4*)(posk + 32 + 8 * g + 4 * hi);
#pragma unroll
                for (int e = 0; e < 4; ++e) { int ia = ka[e] - pq; ia = ia < -128 ? -128 : (ia > 128 ? 128 : ia); int ib = kb[e] - pq; ib = ib < -128 ? -128 : (ib > 128 ? 128 : ib);
                    p0[4 * g + e] += lut[ia + 128]; p1[4 * g + e] += lut[ib + 128]; } }
        }
    }
    alpha = 1.f;
    if (chk) {
    float pmax = p0[0];
#pragma unroll
    for (int r = 1; r < 16; ++r) pmax = fmaxf(pmax, p0[r]);
#pragma unroll
    for (int r = 0; r < 16; ++r) pmax = fmaxf(pmax, p1[r]);
    { auto rr = __builtin_amdgcn_permlane32_swap(__float_as_uint(pmax), __float_as_uint(pmax), false, false);
      pmax = fmaxf(__uint_as_float(rr[0]), __uint_as_float(rr[1])); }
    if (__builtin_expect(first || !__all(pmax <= THR2), 0)) {
        const float d = first ? pmax : fmaxf(pmax, 0.f);
        if (!first) alpha = __builtin_amdgcn_exp2f(-d);
        m_reg += d;
#pragma unroll
        for (int r = 0; r < 16; ++r) { p0[r] -= d; p1[r] -= d; }
    }
    }
#pragma unroll
    for (int r = 0; r < 16; ++r) p0[r] = __builtin_amdgcn_exp2f(p0[r]);
}
template <int BASE> __device__ __forceinline__ bf16x8 pk8r(const f32x16& P) {
    u32x4 w = {cvtpk(P[BASE + 0], P[BASE + 1]), cvtpk(P[BASE + 2], P[BASE + 3]), cvtpk(P[BASE + 4], P[BASE + 5]), cvtpk(P[BASE + 6], P[BASE + 7])}; return *reinterpret_cast<bf16x8*>(&w);
}
template <int BASE> __device__ __forceinline__ bf16x8 pk8(const f32x16& P) {
    const unsigned a0 = cvtpk(P[BASE + 0], P[BASE + 1]), a1 = cvtpk(P[BASE + 2], P[BASE + 3]), b0 = cvtpk(P[BASE + 4], P[BASE + 5]), b1 = cvtpk(P[BASE + 6], P[BASE + 7]);
    auto r0 = __builtin_amdgcn_permlane32_swap(a0, b0, false, false); auto r1 = __builtin_amdgcn_permlane32_swap(a1, b1, false, false);
    u32x4 w = {r0[0], r1[0], r0[1], r1[1]}; return *reinterpret_cast<bf16x8*>(&w);
}
__device__ __forceinline__ void finishSM(f32x16& p0, f32x16& p1, float alpha, float& l_reg, bf16x8& pa0, bf16x8& pa1, bf16x8& pa2, bf16x8& pa3) {
#pragma unroll
    for (int r = 0; r < 16; ++r) p1[r] = __builtin_amdgcn_exp2f(p1[r]);
    float ps = 0;
#pragma unroll
    for (int r = 0; r < 16; ++r) ps += p0[r];
#pragma unroll
    for (int r = 0; r < 16; ++r) ps += p1[r];
    { auto rr = __builtin_amdgcn_permlane32_swap(__float_as_uint(ps), __float_as_uint(ps), false, false);
      ps = __uint_as_float(rr[0]) + __uint_as_float(rr[1]); }
    l_reg = l_reg * alpha + ps;
#define PK4(P, BASE, OUT) do { unsigned a0 = cvtpk(P[BASE + 0], P[BASE + 1]), a1 = cvtpk(P[BASE + 2], P[BASE + 3]);   \
    unsigned b0 = cvtpk(P[BASE + 4], P[BASE + 5]), b1 = cvtpk(P[BASE + 6], P[BASE + 7]);                              \
    auto r0 = __builtin_amdgcn_permlane32_swap(a0, b0, false, false); auto r1 = __builtin_amdgcn_permlane32_swap(a1, b1, false, false); \
    u32x4 w = {r0[0], r1[0], r0[1], r1[1]}; OUT = *reinterpret_cast<bf16x8*>(&w); } while (0)
    PK4(p0, 0, pa0); PK4(p0, 8, pa1); PK4(p1, 0, pa2); PK4(p1, 8, pa3);
#undef PK4
}

template <int DQK, bool BIAS>
__device__ __forceinline__ void attn_unit(const bf16_t* __restrict__ Qb, int ldq, const bf16_t* __restrict__ K1, int ldk1, const bf16_t* __restrict__ K2,
                                          const bf16_t* __restrict__ Vh, int ldv, bf16_t* __restrict__ Ob, int ldo, const float* __restrict__ ropeq,
                                          const int* __restrict__ posb, const int* __restrict__ pmmb, int q0, const float* __restrict__ lutg, float C, int seq, char* lds, const int tid) {
    const int wid = tid >> 6, lane = tid & 63, r32 = lane & 31, hi = lane >> 5;
    char* V_lds = lds + OFF_V; char* K_lds = lds + OFF_K; char* K2_lds = lds + OFF_K2;
    float* ws = (float*)(lds + OFF_WS) + wid * 64; float* li_l = ws; float* al_l = ws + 32; float* lut = (float*)(lds + OFF_LUT);
    float m_reg = -1e30f, l_reg = 0; f32x16 o[4] = {}; bf16x8 qr[8]; char* qrl = lds + OFF_QR + wid * QRB;
    const bf16_t* Qw = Qb + (long)(wid * QBLK + r32) * ldq + hi * 8;
#pragma unroll
    for (int d0 = 0; d0 < (DQK == 192 ? 4 : 8); ++d0) qr[d0] = *reinterpret_cast<const bf16x8*>(Qw + d0 * 16);
    if constexpr (DQK == 192) {
#pragma unroll
        for (int d0 = 4; d0 < 8; ++d0) *reinterpret_cast<bf16x8*>(qrl + kswz(r32, 128 + ((d0 - 4) * 16 + hi * 8) * 2)) = *reinterpret_cast<const bf16x8*>(Qw + d0 * 16);
        const float* rp = ropeq + (long)(wid * QBLK + r32) * 64;
#pragma unroll
        for (int pr = 0; pr < 2; ++pr) {
            const u32x4 x1 = *reinterpret_cast<const u32x4*>(Qw + (8 + pr) * 16), x2 = *reinterpret_cast<const u32x4*>(Qw + (10 + pr) * 16); u32x4 y1, y2;
#pragma unroll
            for (int w = 0; w < 4; ++w) { const f32x4 cs = *(const f32x4*)(rp + (pr * 16 + hi * 8 + 2 * w) * 2);
                const float a0 = bf_lo(x1[w]), a1 = bf_hi(x1[w]), b0 = bf_lo(x2[w]), b1 = bf_hi(x2[w]);
                y1[w] = cvtpk(a0 * cs[0] - b0 * cs[1], a1 * cs[2] - b1 * cs[3]); y2[w] = cvtpk(b0 * cs[0] + a0 * cs[1], b1 * cs[2] + a1 * cs[3]); }
            *reinterpret_cast<u32x4*>(qrl + kswz(r32, (pr * 16 + hi * 8) * 2)) = y1; *reinterpret_cast<u32x4*>(qrl + kswz(r32, ((2 + pr) * 16 + hi * 8) * 2)) = y2;
        }
    }
    unsigned cls_pack = 0; int pq = 0; float bneg2 = 0.f, bpos2 = 0.f;
    if constexpr (BIAS) {
        const int qg = (q0 >> 5) + wid; const int qmin = pmmb[2 * qg], qmax = pmmb[2 * qg + 1];
#pragma unroll
        for (int t4 = 0; t4 < 4; ++t4) { const int tl = lane * 4 + t4;
            const i32x4 mm = *(const i32x4*)(pmmb + 4 * tl); const int kmin = min(mm[0], mm[2]), kmax = max(mm[1], mm[3]);
            const unsigned c = (kmin - qmax >= 91) ? 1u : ((qmin - kmax >= 91) ? 0u : 2u); cls_pack |= c << (2 * t4); }
        pq = posb[q0 + wid * QBLK + r32];
        for (int i = tid; i < 257; i += 512) lut[i] = lutg[i];
        bneg2 = lutg[0]; bpos2 = lutg[256];
    }
    const int sr = tid >> 4, sc = (tid & 15) * 8, vst0 = v_st(sr, sc), vst1 = v_st(32 + sr, sc);
    const int s2r = tid >> 3, s2c = (tid & 7) * 8;
    const int vb0 = (int)(uintptr_t)V_lds + v_rd_base(lane);
    bf16x8 vs0, vs1, ks0, ks1, k2s;
    const unsigned vo0 = (unsigned)(sr * ldv + sc) * 2u, vo1 = vo0 + (unsigned)(32 * ldv) * 2u, ko0 = (unsigned)(sr * ldk1 + sc) * 2u, ko1 = ko0 + (unsigned)(32 * ldk1) * 2u, k2o = (unsigned)(s2r * 64 + s2c) * 2u;
#define SLOAD(k0) do { const char* vt_ = (const char*)Vh + (size_t)(k0) * ldv * 2; const char* kt_ = (const char*)K1 + (size_t)(k0) * ldk1 * 2; \
    vs0 = *reinterpret_cast<const bf16x8*>(vt_ + vo0); vs1 = *reinterpret_cast<const bf16x8*>(vt_ + vo1); \
    ks0 = *reinterpret_cast<const bf16x8*>(kt_ + ko0); ks1 = *reinterpret_cast<const bf16x8*>(kt_ + ko1); \
    if constexpr (DQK == 192) k2s = *reinterpret_cast<const bf16x8*>((const char*)K2 + (size_t)(k0) * 128 + k2o); } while (0)
#define SWRITE(b) do { *(bf16x8*)(V_lds + (b) * SHM_V + vst0) = vs0; *(bf16x8*)(V_lds + (b) * SHM_V + vst1) = vs1; \
    *(bf16x8*)(K_lds + (b) * SHM_K + kswz(sr, sc * 2)) = ks0; *(bf16x8*)(K_lds + (b) * SHM_K + kswz(32 + sr, sc * 2)) = ks1; \
    if constexpr (DQK == 192) *(bf16x8*)(K2_lds + (b) * SHM_K2 + k2swz(s2r, s2c * 2)) = k2s; } while (0)
#define RESC(a) do { if (__any((a) < 1.f)) { if (hi == 0) al_l[r32] = (a); asm volatile("s_waitcnt lgkmcnt(0)" ::: "memory"); \
    _Pragma("unroll") for (int d = 0; d < 4; ++d) _Pragma("unroll") for (int r = 0; r < 16; ++r) o[d][r] *= al_l[crow(r, hi)]; } } while (0)
#define TCLS(t, TB, SL) do { if constexpr (BIAS) { const unsigned cw_ = (unsigned)__builtin_amdgcn_readlane((int)cls_pack, (t) >> 2); const unsigned c_ = (cw_ >> (2 * ((t) & 3))) & 3u; \
    SL = (c_ == 2u); TB = (c_ == 1u) ? bpos2 : bneg2; } else { SL = false; TB = 0.f; } } while (0)
    f32x16 pA0, pA1, pB0, pB1; float alA, alB; bf16x8 pa0, pa1, pa2, pa3; const int NT = seq / KVBLK;
    float tbx; bool slx;
    SLOAD(0); asm volatile("s_waitcnt vmcnt(0)" ::: "memory"); SWRITE(0); __syncthreads();
    qkt<DQK>(pA0, pA1, K_lds, K2_lds, qr, qrl, r32, hi); TCLS(0, tbx, slx); partialSM<BIAS>(pA0, pA1, m_reg, alA, C, tbx, slx, posb, pq, lut, hi);
    SLOAD(KVBLK);
    asm volatile("s_waitcnt vmcnt(0)" ::: "memory"); SWRITE(1); __syncthreads();
    for (int j = 1; j + 1 < NT; j += 2) {
        SBAR(); qkt<DQK>(pB0, pB1, K_lds + SHM_K, K2_lds + SHM_K2, qr, qrl, r32, hi);
        finishSM(pA0, pA1, alA, l_reg, pa0, pa1, pa2, pa3); SBAR();
        SLOAD((j + 1) * KVBLK); SBAR();
        pv_d0(o, vb0, pa0, pa1, pa2, pa3); TCLS(j, tbx, slx); partialSM<BIAS>(pB0, pB1, m_reg, alB, C, tbx, slx, posb + j * KVBLK, pq, lut, hi);
        __syncthreads(); SWRITE(0);
        RESC(alB); __syncthreads();
        SBAR(); qkt<DQK>(pA0, pA1, K_lds, K2_lds, qr, qrl, r32, hi);
        finishSM(pB0, pB1, alB, l_reg, pa0, pa1, pa2, pa3); SBAR();
        SLOAD((j + 2 < NT ? j + 2 : j + 1) * KVBLK); SBAR();
        pv_d0(o, vb0 + SHM_V, pa0, pa1, pa2, pa3); TCLS(j + 1, tbx, slx); partialSM<BIAS>(pA0, pA1, m_reg, alA, C, tbx, slx, posb + (j + 1) * KVBLK, pq, lut, hi);
        __syncthreads(); SWRITE(1);
        RESC(alA); __syncthreads();
    }
    SBAR(); qkt<DQK>(pB0, pB1, K_lds + SHM_K, K2_lds + SHM_K2, qr, qrl, r32, hi);
    finishSM(pA0, pA1, alA, l_reg, pa0, pa1, pa2, pa3); SBAR();
    pv_d0(o, vb0, pa0, pa1, pa2, pa3); TCLS(NT - 1, tbx, slx); partialSM<BIAS>(pB0, pB1, m_reg, alB, C, tbx, slx, posb + (NT - 1) * KVBLK, pq, lut, hi);
    __syncthreads(); RESC(alB);
    finishSM(pB0, pB1, alB, l_reg, pa0, pa1, pa2, pa3); SBAR();
    pv_d0(o, vb0 + SHM_V, pa0, pa1, pa2, pa3);
    if (hi == 0) li_l[r32] = l_reg; asm volatile("s_waitcnt lgkmcnt(0)" ::: "memory");
    float rli[16];
#pragma unroll
    for (int r = 0; r < 16; ++r) rli[r] = __builtin_amdgcn_rcpf(li_l[crow(r, hi)]);
    __syncthreads();
    bf16_t* stg = (bf16_t*)(lds + wid * 8192);
#pragma unroll
    for (int r = 0; r < 16; ++r) { const int orow = crow(r, hi);
#pragma unroll
        for (int d0 = 0; d0 < 4; ++d0) stg[orow * 128 + d0 * 32 + r32] = (bf16_t)f2bf(o[d0][r] * rli[r]); }
    asm volatile("s_waitcnt lgkmcnt(0)" ::: "memory");
    bf16_t* Ow = Ob + (long)(wid * QBLK) * ldo;
#pragma unroll
    for (int i = 0; i < 8; ++i) { const int row = i * 4 + (lane >> 4), ch = lane & 15; const u32x4 v = *(const u32x4*)(stg + row * 128 + ch * 8); *(u32x4*)(Ow + (long)row * ldo + ch * 8) = v; }
    __syncthreads();
#undef SLOAD
#undef SWRITE
#undef RESC
#undef TCLS
}

template <int OFF> __device__ __forceinline__ bf16x8 rd128(int a) { bf16x8 r; asm volatile("ds_read_b128 %0, %1 offset:%2" : "=&v"(r) : "v"(a), "i"(OFF) : "memory"); return r; }
template <int N> __device__ __forceinline__ void waitl() { asm volatile("s_waitcnt lgkmcnt(%0)" :: "i"(N) : "memory"); }
template <int DQK, bool QL, int I> __device__ __forceinline__ void qk_rd(bf16x8& fa, bf16x8& fb, bf16x8& fq, int kb, int k2b, int qlb) {
    if constexpr (I < 8) { fa = rd128<I * 32>(kb); fb = rd128<32 * KP + I * 32>(kb); if constexpr (QL && I >= 4) fq = rd128<(I - 4) * 32>(qlb); }
    else { fa = rd128<(I - 8) * 32>(k2b); fb = rd128<32 * K2P + (I - 8) * 32>(k2b); }
}
template <int DQK, bool QL, int I> __device__ __forceinline__ void qk_steps(f32x16& p0, f32x16& p1, int kb, int k2b, int qlb, const bf16x8* qr,
                                                                            bf16x8& fa0, bf16x8& fb0, bf16x8& fq0, bf16x8& fa1, bf16x8& fb1, bf16x8& fq1) {
    constexpr int NI = DQK / 16;
    if constexpr (I + 1 < NI) qk_rd<DQK, QL, I + 1>(fa1, fb1, fq1, kb, k2b, qlb);
    waitl<(I + 1 < NI) ? ((QL && I + 1 >= 4 && I + 1 < 8) ? 3 : 2) : 0>(); SBAR();
    bf16x8 q; if constexpr (QL && I >= 4 && I < 8) q = fq0; else q = qr[I];
    p0 = __builtin_amdgcn_mfma_f32_32x32x16_bf16(fa0, q, p0, 0, 0, 0);
    p1 = __builtin_amdgcn_mfma_f32_32x32x16_bf16(fb0, q, p1, 0, 0, 0);
    SBAR();
    if constexpr (I + 1 < NI) qk_steps<DQK, QL, I + 1>(p0, p1, kb, k2b, qlb, qr, fa1, fb1, fq1, fa0, fb0, fq0);
}
template <int DQK, bool QL> __device__ __forceinline__ void qkt_pipe(f32x16& p0, f32x16& p1, int kb, int k2b, int qlb, const bf16x8* qr) {
    p0 = f32x16{}; p1 = f32x16{};
    bf16x8 fa0, fb0, fq0, fa1, fb1, fq1;
    SBAR(); qk_rd<DQK, QL, 0>(fa0, fb0, fq0, kb, k2b, qlb);
    qk_steps<DQK, QL, 0>(p0, p1, kb, k2b, qlb, qr, fa0, fb0, fq0, fa1, fb1, fq1);
}
template <int BLK> __device__ __forceinline__ void pv_rd(s16x4 (&L)[4], s16x4 (&H)[4], int vb) {
    constexpr int base = (BLK >> 2) * 16384, D0 = BLK & 3;
    L[0] = tr_read<base + v_rd_off(D0, 0, 0)>(vb); H[0] = tr_read<base + v_rd_off(D0, 0, 1)>(vb); L[1] = tr_read<base + v_rd_off(D0, 1, 0)>(vb); H[1] = tr_read<base + v_rd_off(D0, 1, 1)>(vb);
    L[2] = tr_read<base + v_rd_off(D0, 2, 0)>(vb); H[2] = tr_read<base + v_rd_off(D0, 2, 1)>(vb); L[3] = tr_read<base + v_rd_off(D0, 3, 0)>(vb); H[3] = tr_read<base + v_rd_off(D0, 3, 1)>(vb);
}
template <int BLK, int KS0> __device__ __forceinline__ void pv_rd2(s16x4 (&L)[2], s16x4 (&H)[2], int vb) {
    constexpr int base = (BLK >> 2) * 16384, D0 = BLK & 3;
    L[0] = tr_read<base + v_rd_off(D0, KS0, 0)>(vb); H[0] = tr_read<base + v_rd_off(D0, KS0, 1)>(vb); L[1] = tr_read<base + v_rd_off(D0, KS0 + 1, 0)>(vb); H[1] = tr_read<base + v_rd_off(D0, KS0 + 1, 1)>(vb);
}
template <int BLK, int NB> __device__ __forceinline__ void pv_steps(f32x16* o, int vb, bf16x8 pa0, bf16x8 pa1, bf16x8 pa2, bf16x8 pa3,
                                                                    s16x4 (&La)[4], s16x4 (&Ha)[4], s16x4 (&Lb)[4], s16x4 (&Hb)[4]) {
    if constexpr (BLK + 1 < NB) pv_rd<BLK + 1>(Lb, Hb, vb);
    waitl<(BLK + 1 < NB) ? 8 : 0>(); SBAR();
#define PK(L, H) (bf16x8){L[0], L[1], L[2], L[3], H[0], H[1], H[2], H[3]}
    o[BLK] = __builtin_amdgcn_mfma_f32_32x32x16_bf16(pa0, PK(La[0], Ha[0]), o[BLK], 0, 0, 0);
    o[BLK] = __builtin_amdgcn_mfma_f32_32x32x16_bf16(pa1, PK(La[1], Ha[1]), o[BLK], 0, 0, 0);
    o[BLK] = __builtin_amdgcn_mfma_f32_32x32x16_bf16(pa2, PK(La[2], Ha[2]), o[BLK], 0, 0, 0);
    o[BLK] = __builtin_amdgcn_mfma_f32_32x32x16_bf16(pa3, PK(La[3], Ha[3]), o[BLK], 0, 0, 0);
#undef PK
    SBAR();
    if constexpr (BLK + 1 < NB) pv_steps<BLK + 1, NB>(o, vb, pa0, pa1, pa2, pa3, Lb, Hb, La, Ha);
}
template <int NB> __device__ __forceinline__ void pv_pipe(f32x16* o, int vb, bf16x8 pa0, bf16x8 pa1, bf16x8 pa2, bf16x8 pa3) {
    s16x4 La[4], Ha[4], Lb[4], Hb[4];
    SBAR(); pv_rd<0>(La, Ha, vb);
    pv_steps<0, NB>(o, vb, pa0, pa1, pa2, pa3, La, Ha, Lb, Hb);
}
constexpr int PP_OFF_WS = 155648, PP_OFF_LUT = 157696;
template <int DQK, int DV, bool BIAS, bool QL>
__device__ __forceinline__ void attn_unit_pp(const bf16_t* __restrict__ Qb, int ldq, const bf16_t* __restrict__ K1, int ldk1, const bf16_t* __restrict__ K2,
                                             const bf16_t* __restrict__ Vh, int ldv, bf16_t* __restrict__ Ob, int ldo, const float* __restrict__ ropeq,
                                             const int* __restrict__ posb, const int* __restrict__ pmmb, int q0, const float* __restrict__ lutg, float C, int seq, char* lds, const int tid) {
    constexpr int NVH = DV / 128, SHM_VX = 16384 * NVH; constexpr bool EARLY = (DV == 128);
    constexpr int P_OFF_V = 0, P_OFF_K = 2 * SHM_VX, P_OFF_K2 = P_OFF_K + 2 * SHM_K, P_OFF_Q = P_OFF_K2 + (DQK == 192 ? 2 * SHM_K2 : 0), QLB = 32 * K2P;
    static_assert(P_OFF_Q + (QL ? NW * QLB : 0) <= PP_OFF_WS && NW * 32 * DV * 2 <= PP_OFF_WS && !(QL && DQK == 192), "pp LDS map");
    const int wid = tid >> 6, lane = tid & 63, r32 = lane & 31, hi = lane >> 5; const int half = __builtin_amdgcn_readfirstlane(wid >> 2);
    char* V_lds = lds + P_OFF_V; char* K_lds = lds + P_OFF_K; char* K2_lds = lds + P_OFF_K2;
    float* ws = (float*)(lds + PP_OFF_WS) + wid * 64; float* li_l = ws; float* al_l = ws + 32; float* lut = (float*)(lds + PP_OFF_LUT);
    float m_reg = -1e30f, l_reg = 0; f32x16 o[4 * NVH] = {}; bf16x8 qr[DQK / 16]; char* qrl = lds + P_OFF_Q + wid * QLB;
    const bf16_t* Qw = Qb + (long)(wid * QBLK + r32) * ldq + hi * 8;
#pragma unroll
    for (int d0 = 0; d0 < DQK / 16; ++d0) { if (QL && d0 >= 4 && d0 < 8) *reinterpret_cast<bf16x8*>(qrl + k2swz(r32, ((d0 - 4) * 16 + hi * 8) * 2)) = *reinterpret_cast<const bf16x8*>(Qw + d0 * 16);
        else qr[d0] = *reinterpret_cast<const bf16x8*>(Qw + d0 * 16); }
    if constexpr (DQK == 192) {
        const float* rp = ropeq + (long)(wid * QBLK + r32) * 64;
#pragma unroll
        for (int pr = 0; pr < 2; ++pr) {
            const u32x4 x1 = *reinterpret_cast<const u32x4*>(&qr[8 + pr]), x2 = *reinterpret_cast<const u32x4*>(&qr[10 + pr]); u32x4 y1, y2;
#pragma unroll
            for (int w = 0; w < 4; ++w) { const f32x4 cs = *(const f32x4*)(rp + (pr * 16 + hi * 8 + 2 * w) * 2);
                const float a0 = bf_lo(x1[w]), a1 = bf_hi(x1[w]), b0 = bf_lo(x2[w]), b1 = bf_hi(x2[w]);
                y1[w] = cvtpk(a0 * cs[0] - b0 * cs[1], a1 * cs[2] - b1 * cs[3]); y2[w] = cvtpk(b0 * cs[0] + a0 * cs[1], b1 * cs[2] + a1 * cs[3]); }
            qr[8 + pr] = *reinterpret_cast<const bf16x8*>(&y1); qr[10 + pr] = *reinterpret_cast<const bf16x8*>(&y2);
        }
    }
    unsigned cls_pack = 0; int pq = 0; float bneg2 = 0.f, bpos2 = 0.f;
    if constexpr (BIAS) {
        const int qg = (q0 >> 5) + wid; const int qmin = pmmb[2 * qg], qmax = pmmb[2 * qg + 1];
#pragma unroll
        for (int t4 = 0; t4 < 4; ++t4) { const int tl = lane * 4 + t4;
            const i32x4 mm = *(const i32x4*)(pmmb + 4 * tl); const int kmin = mm[0] < mm[2] ? mm[0] : mm[2], kmax = mm[1] > mm[3] ? mm[1] : mm[3];
            const unsigned c = (kmin - qmax >= 91) ? 1u : ((qmin - kmax >= 91) ? 0u : 2u); cls_pack |= c << (2 * t4); }
        pq = posb[q0 + wid * QBLK + r32];
        for (int i = tid; i < 257; i += 512) lut[i] = lutg[i];
        bneg2 = lutg[0]; bpos2 = lutg[256];
    }
    const int sr = tid >> 4, sc = (tid & 15) * 8, vst0 = v_st(sr, sc), vst1 = v_st(32 + sr, sc);
    const int s2r = tid >> 3, s2c = (tid & 7) * 8;
    const int vb0 = (int)(uintptr_t)V_lds + v_rd_base(lane);
    const int kb0 = (int)(uintptr_t)K_lds + r32 * KP + hi * 16, k2b0 = (int)(uintptr_t)K2_lds + r32 * K2P + hi * 16, qlb0 = (int)(uintptr_t)qrl + r32 * K2P + hi * 16;
    const unsigned vo0 = (unsigned)(sr * ldv + sc) * 2u, vo1 = vo0 + (unsigned)(32 * ldv) * 2u, ko0 = (unsigned)(sr * ldk1 + sc) * 2u, ko1 = ko0 + (unsigned)(32 * ldk1) * 2u, k2o = (unsigned)(s2r * 64 + s2c) * 2u;
    bf16x8 sv[2 * NVH], sk0, sk1, sk2;
#define BAR() do { asm volatile("s_waitcnt lgkmcnt(0)" ::: "memory"); __builtin_amdgcn_s_barrier(); asm volatile("" ::: "memory"); } while (0)
#define KLOAD(t) do { const char* kt_ = (const char*)K1 + (size_t)(t) * KVBLK * ldk1 * 2; sk0 = *reinterpret_cast<const bf16x8*>(kt_ + ko0); sk1 = *reinterpret_cast<const bf16x8*>(kt_ + ko1); \
    if constexpr (DQK == 192) sk2 = *reinterpret_cast<const bf16x8*>((const char*)K2 + (size_t)(t) * KVBLK * 128 + k2o); } while (0)
#define VLOAD(t) do { const char* vt_ = (const char*)Vh + (size_t)(t) * KVBLK * ldv * 2; _Pragma("unroll") for (int h_ = 0; h_ < NVH; ++h_) { \
    sv[2 * h_] = *reinterpret_cast<const bf16x8*>(vt_ + vo0 + (size_t)h_ * (SEQ * 256)); sv[2 * h_ + 1] = *reinterpret_cast<const bf16x8*>(vt_ + vo1 + (size_t)h_ * (SEQ * 256)); } } while (0)
#define KWRITE(b) do { *(bf16x8*)(K_lds + (b) * SHM_K + kswz(sr, sc * 2)) = sk0; *(bf16x8*)(K_lds + (b) * SHM_K + kswz(32 + sr, sc * 2)) = sk1; \
    if constexpr (DQK == 192) *(bf16x8*)(K2_lds + (b) * SHM_K2 + k2swz(s2r, s2c * 2)) = sk2; } while (0)
#define VWRITE(b) do { _Pragma("unroll") for (int h_ = 0; h_ < NVH; ++h_) { *(bf16x8*)(V_lds + (b) * SHM_VX + h_ * 16384 + vst0) = sv[2 * h_]; *(bf16x8*)(V_lds + (b) * SHM_VX + h_ * 16384 + vst1) = sv[2 * h_ + 1]; } } while (0)
#define TCLS(t, TB, SL) do { if constexpr (BIAS) { const unsigned cw_ = (unsigned)__builtin_amdgcn_readlane((int)cls_pack, (t) >> 2); const unsigned c_ = (cw_ >> (2 * ((t) & 3))) & 3u; \
    SL = (c_ == 2u); TB = (c_ == 1u) ? bpos2 : bneg2; } else { SL = false; TB = 0.f; } } while (0)
    const int NT = seq / KVBLK;
    KLOAD(0); VLOAD(0); KWRITE(0); VWRITE(0); BAR();
    KLOAD(1); if constexpr (EARLY) VLOAD(1);
    if (half && PP_STAGGER) BAR();
    f32x16 p0, p1; float al, tbx; bool slx; bf16x8 pa0, pa1, pa2, pa3;
    for (int j = 0; j < NT; ++j) {
        const int b = j & 1;
        qkt_pipe<DQK, QL>(p0, p1, kb0 + b * SHM_K, k2b0 + b * SHM_K2, qlb0, qr);
        float cmx, offx;
        TCLS(j, tbx, slx); partialSM<BIAS, true>(p0, p1, m_reg, al, C, tbx, slx, posb + j * KVBLK, pq, lut, hi, &cmx, &offx);
        if (__any(al < 1.f)) { if (hi == 0) al_l[r32] = al; asm volatile("s_waitcnt lgkmcnt(0)" ::: "memory");
#pragma unroll
            for (int d = 0; d < 4 * NVH; ++d)
#pragma unroll
                for (int r = 0; r < 16; ++r) o[d][r] *= al_l[crow(r, hi)]; }
        if (j + 1 < NT) { KWRITE(b ^ 1); if constexpr (EARLY) { if (j + 2 < NT) KLOAD(j + 2); } else VLOAD(j + 1); }
        if (PP_STAGGER) BAR();
        {
            constexpr int NB = 4 * NVH, EPB = 16 / NB; const int vb_ = vb0 + b * SHM_VX;
            float ps = 0.f;
#pragma unroll
            for (int r = 0; r < 16; ++r) ps += p0[r];
            pa0 = pk8<0>(p0); pa1 = pk8<8>(p0);
            s16x4 L[2][2], H[2][2];
#define PK(L_, H_) (bf16x8){L_[0], L_[1], L_[2], L_[3], H_[0], H_[1], H_[2], H_[3]}
#define PVBLK(B, KS0, PX, PY) do { if constexpr ((B) + 1 < NB) pv_rd2<((B) + 1 < NB ? (B) + 1 : 0), KS0>(L[((B) + 1) & 1], H[((B) + 1) & 1], vb_); waitl<((B) + 1 < NB) ? 4 : 0>(); SBAR(); \
    o[B] = __builtin_amdgcn_mfma_f32_32x32x16_bf16(PX, PK(L[(B) & 1][0], H[(B) & 1][0]), o[B], 0, 0, 0); o[B] = __builtin_amdgcn_mfma_f32_32x32x16_bf16(PY, PK(L[(B) & 1][1], H[(B) & 1][1]), o[B], 0, 0, 0); SBAR(); } while (0)
#define SMCHUNK(B) do { _Pragma("unroll") for (int r_ = (B) * EPB; r_ < (B) * EPB + EPB; ++r_) { p1[r_] = __builtin_amdgcn_exp2f(fmaf(p1[r_], cmx, offx)); ps += p1[r_]; } \
    if constexpr ((B) * EPB + EPB == 8) pa2 = pk8<0>(p1); SBAR(); } while (0)
            SBAR(); pv_rd2<0, 0>(L[0], H[0], vb_);
            PVBLK(0, 0, pa0, pa1); SMCHUNK(0); PVBLK(1, 0, pa0, pa1); SMCHUNK(1); PVBLK(2, 0, pa0, pa1); SMCHUNK(2); PVBLK(3, 0, pa0, pa1); SMCHUNK(3);
            if constexpr (NB == 8) { PVBLK(4, 0, pa0, pa1); SMCHUNK(4); PVBLK(5, 0, pa0, pa1); SMCHUNK(5); PVBLK(6, 0, pa0, pa1); SMCHUNK(6); PVBLK(7, 0, pa0, pa1); SMCHUNK(7); }
            pa3 = pk8<8>(p1);
            { auto rr = __builtin_amdgcn_permlane32_swap(__float_as_uint(ps), __float_as_uint(ps), false, false); ps = __uint_as_float(rr[0]) + __uint_as_float(rr[1]); }
            l_reg = l_reg * al + ps;
            SBAR(); pv_rd2<0, 2>(L[0], H[0], vb_);
            PVBLK(0, 2, pa2, pa3); PVBLK(1, 2, pa2, pa3); PVBLK(2, 2, pa2, pa3); PVBLK(3, 2, pa2, pa3);
            if constexpr (NB == 8) { PVBLK(4, 2, pa2, pa3); PVBLK(5, 2, pa2, pa3); PVBLK(6, 2, pa2, pa3); PVBLK(7, 2, pa2, pa3); }
#undef PK
#undef PVBLK
#undef SMCHUNK
        }
        if (j + 1 < NT) { VWRITE(b ^ 1); if (j + 2 < NT) { if constexpr (EARLY) VLOAD(j + 2); else KLOAD(j + 2); } }
        BAR();
    }
    if (!half && PP_STAGGER) BAR();
    if (hi == 0) li_l[r32] = l_reg; asm volatile("s_waitcnt lgkmcnt(0)" ::: "memory");
    float rli[16];
#pragma unroll
    for (int r = 0; r < 16; ++r) rli[r] = __builtin_amdgcn_rcpf(li_l[crow(r, hi)]);
    bf16_t* stg = (bf16_t*)(lds + wid * (32 * DV * 2));
#pragma unroll
    for (int r = 0; r < 16; ++r) { const int orow = crow(r, hi);
#pragma unroll
        for (int d0 = 0; d0 < 4 * NVH; ++d0) stg[orow * DV + d0 * 32 + r32] = (bf16_t)f2bf(o[d0][r] * rli[r]); }
    asm volatile("s_waitcnt lgkmcnt(0)" ::: "memory");
    bf16_t* Ow = Ob + (long)(wid * QBLK) * ldo;
    constexpr int CPR = DV / 8, RPI = 64 / CPR;
#pragma unroll
    for (int i = 0; i < 32 / RPI; ++i) { const int row = i * RPI + lane / CPR, ch = lane % CPR; const u32x4 v = *(const u32x4*)(stg + row * DV + ch * 8); *(u32x4*)(Ow + (long)row * ldo + ch * 8) = v; }
    __syncthreads();
#undef BAR
#undef KLOAD
#undef VLOAD
#undef KWRITE
#undef VWRITE
#undef TCLS
}

template <int V> struct IC { static constexpr int value = V; };
template <int I, int KOFF, int K2OFF> __device__ __forceinline__ void qk3_rd(bf16x8& fa, bf16x8& fb, int kbuf, int krel, int k2buf, int k2rel) {
    if constexpr (I < 8) { const int a = kbuf + (krel ^ (I << 5)); fa = rd128<KOFF>(a); fb = rd128<KOFF + 8192>(a); }
    else { const int a = k2buf + (k2rel ^ ((I - 8) << 5)); fa = rd128<K2OFF>(a); fb = rd128<K2OFF + 4096>(a); }
}
template <int NI, int I, int KOFF, int K2OFF> __device__ __forceinline__ void qk3_steps(f32x16& p0, f32x16& p1, const f32x16& cinit, int kbuf, int krel, int k2buf, int k2rel, const bf16x8* qr, bf16x8& a0, bf16x8& b0, bf16x8& a1, bf16x8& b1, bf16x8& a2, bf16x8& b2) {
    if constexpr (I + 2 < NI) qk3_rd<I + 2, KOFF, K2OFF>(a2, b2, kbuf, krel, k2buf, k2rel);
    waitl<(I + 2 < NI) ? 4 : ((I + 1 < NI) ? 2 : 0)>(); SBAR();
    if constexpr (I == 0) { p0 = __builtin_amdgcn_mfma_f32_32x32x16_bf16(a0, qr[I], cinit, 0, 0, 0); p1 = __builtin_amdgcn_mfma_f32_32x32x16_bf16(b0, qr[I], cinit, 0, 0, 0); }
    else { p0 = __builtin_amdgcn_mfma_f32_32x32x16_bf16(a0, qr[I], p0, 0, 0, 0); p1 = __builtin_amdgcn_mfma_f32_32x32x16_bf16(b0, qr[I], p1, 0, 0, 0); }
    SBAR();
    if constexpr (I + 1 < NI) qk3_steps<NI, I + 1, KOFF, K2OFF>(p0, p1, cinit, kbuf, krel, k2buf, k2rel, qr, a1, b1, a2, b2, a0, b0);
}
typedef short v4i16_t __attribute__((ext_vector_type(4)));
__device__ __forceinline__ s16x4 vtr(const LAS unsigned char* p) { return __builtin_bit_cast(s16x4, __builtin_amdgcn_ds_read_tr16_b64_v4i16((LAS v4i16_t*)p)); }
template <int BLK, int KS0> __device__ __forceinline__ void pv_rd2c(s16x4 (&L)[2], s16x4 (&H)[2], const LAS unsigned char* vp) {
    constexpr int base = (BLK >> 2) * 16384, D0 = BLK & 3;
    L[0] = vtr(vp + base + v_rd_off(D0, KS0, 0)); H[0] = vtr(vp + base + v_rd_off(D0, KS0, 1)); L[1] = vtr(vp + base + v_rd_off(D0, KS0 + 1, 0)); H[1] = vtr(vp + base + v_rd_off(D0, KS0 + 1, 1));
}
__device__ __forceinline__ void glds_s(const void* sbase, unsigned voff, unsigned ldsaddr) {
    unsigned keep;
    asm volatile("s_mov_b32 %0, m0\n\ts_mov_b32 m0, %3\n\ts_nop 0\n\tglobal_load_lds_dwordx4 %1, %2\n\ts_mov_b32 m0, %0" : "=&s"(keep) : "v"(voff), "s"(sbase), "s"(ldsaddr) : "memory");
}
struct FuseArgs { const bf16_t* O0; bf16_t* Hout; const float* g; float lam, oml; };
template <int DQK, int DV, bool BIAS, bool FUSE = false>
__device__ __forceinline__ void attn_unit_dma(const bf16_t* __restrict__ Qb, int ldq, const bf16_t* __restrict__ K1, int ldk1, const bf16_t* __restrict__ K2, const bf16_t* __restrict__ Vh, int ldv, bf16_t* __restrict__ Ob, int ldo,
                                              const float* __restrict__ ropeq, const int* __restrict__ posb, const int* __restrict__ pmmb, int q0, const float* __restrict__ lutg, float C, int seq, char* lds, LAS unsigned char* ldsl, const int tid, const FuseArgs fa = FuseArgs{}) {
    constexpr bool NEGM = true, NEGP = (DV == 128);
    constexpr int NVH = DV / 128, SHM_VX = 16384 * NVH, SHM_KD = 16384, SHM_K2D = 8192, P_OFF_V = 0, P_OFF_K = 2 * SHM_VX, P_OFF_K2 = P_OFF_K + 2 * SHM_KD;
    static_assert(P_OFF_K2 + (DQK == 192 ? 2 * SHM_K2D : 0) <= PP_OFF_WS && NW * 32 * DV * 2 <= PP_OFF_WS, "dma LDS map");
    const int wid = tid >> 6, lane = tid & 63, r32 = lane & 31, hi = lane >> 5; const int widu = __builtin_amdgcn_readfirstlane(wid);
    char* V_lds = lds + P_OFF_V; char* K_lds = lds + P_OFF_K;
    float* ws = (float*)(lds + PP_OFF_WS) + widu * 64; float* li_l = ws; float* al_l = ws + 32; float* lut = (float*)(lds + PP_OFF_LUT);
    float m_reg = NEGM ? 0.f : -1e30f, l_reg = 0; f32x16 o[4 * NVH] = {}; bf16x8 qr[DQK / 16];
    const bf16_t* Qw = Qb + (long)(wid * QBLK + r32) * ldq + hi * 8;
#pragma unroll
    for (int d0 = 0; d0 < DQK / 16; ++d0) qr[d0] = *reinterpret_cast<const bf16x8*>(Qw + d0 * 16);
    if constexpr (DQK == 192) {
        const float* rp = ropeq + (long)(wid * QBLK + r32) * 64;
#pragma unroll
        for (int pr = 0; pr < 2; ++pr) {
            const u32x4 x1 = *reinterpret_cast<const u32x4*>(&qr[8 + pr]), x2 = *reinterpret_cast<const u32x4*>(&qr[10 + pr]); u32x4 y1, y2;
#pragma unroll
            for (int w = 0; w < 4; ++w) { const f32x4 cs = *(const f32x4*)(rp + (pr * 16 + hi * 8 + 2 * w) * 2);
                const float a0 = bf_lo(x1[w]), a1 = bf_hi(x1[w]), b0 = bf_lo(x2[w]), b1 = bf_hi(x2[w]);
                y1[w] = cvtpk(a0 * cs[0] - b0 * cs[1], a1 * cs[2] - b1 * cs[3]); y2[w] = cvtpk(b0 * cs[0] + a0 * cs[1], b1 * cs[2] + a1 * cs[3]); }
            qr[8 + pr] = *reinterpret_cast<const bf16x8*>(&y1); qr[10 + pr] = *reinterpret_cast<const bf16x8*>(&y2);
        }
    }
    if constexpr (NEGM)
#pragma unroll
    for (int d0 = 0; d0 < DQK / 16; ++d0) {
        const u32x4 x = *reinterpret_cast<const u32x4*>(&qr[d0]); u32x4 y;
#pragma unroll
        for (int w = 0; w < 4; ++w) y[w] = cvtpk(bf_lo(x[w]) * C, bf_hi(x[w]) * C);
        qr[d0] = *reinterpret_cast<const bf16x8*>(&y); }
    unsigned cls_pack = 0; int pq = 0; float bneg2 = 0.f, bpos2 = 0.f;
    if constexpr (BIAS) {
        const int qg = (q0 >> 5) + wid; const int qmin = pmmb[2 * qg], qmax = pmmb[2 * qg + 1];
#pragma unroll
        for (int t4 = 0; t4 < 4; ++t4) { const int tl = lane * 4 + t4;
            const i32x4 mm = *(const i32x4*)(pmmb + 4 * tl); const int kmin = mm[0] < mm[2] ? mm[0] : mm[2], kmax = mm[1] > mm[3] ? mm[1] : mm[3];
            const unsigned c = (kmin - qmax >= 91) ? 1u : ((qmin - kmax >= 91) ? 0u : 2u); cls_pack |= c << (2 * t4); }
        pq = posb[q0 + wid * QBLK + r32];
        for (int i = tid; i < 257; i += 512) lut[i] = lutg[i];
        bneg2 = __builtin_bit_cast(float, __builtin_amdgcn_readfirstlane(__builtin_bit_cast(int, lutg[0]))); bpos2 = __builtin_bit_cast(float, __builtin_amdgcn_readfirstlane(__builtin_bit_cast(int, lutg[256])));
    }
    const int krow = 4 * wid + (lane >> 4), kfw = (krow & 7) | (((krow >> 4) & 1) << 3);
    const unsigned kof = (unsigned)krow * (unsigned)(ldk1 * 2) + (unsigned)(((lane & 15) ^ kfw) << 4);
    const int vsub = 2 * wid + (lane >> 5), vk = (vsub >> 2) * 8 + ((lane & 31) >> 2);
    const unsigned vof = (unsigned)vk * (unsigned)(ldv * 2) + (unsigned)(((vsub & 3) * 32 + (lane & 3) * 8) * 2);
    const int k2row = 8 * wid + (lane >> 3); const unsigned k2of = (unsigned)k2row * 128u + (unsigned)(((lane & 7) ^ ((k2row >> 1) & 7)) << 4);
    const int k2rel = r32 * 128 + ((hi ^ ((r32 >> 1) & 7)) << 4), k2buf0 = (int)(uintptr_t)(lds + P_OFF_K2);
    const int vb0 = (int)(uintptr_t)V_lds + v_rd_base(lane);
    const unsigned ldsb = (unsigned)(uintptr_t)ldsl;
    const int kfr = (r32 & 7) | (((r32 >> 4) & 1) << 3), krel = r32 * 256 + ((hi ^ kfr) << 4), kbuf0 = (int)(uintptr_t)K_lds;
#define DMA(t, b) do { const char* kt_ = (const char*)K1 + (size_t)(t) * KVBLK * ldk1 * 2; const char* vt_ = (const char*)Vh + (size_t)(t) * KVBLK * ldv * 2; \
    const unsigned kd_ = ldsb + P_OFF_K + (b) * SHM_KD + widu * 1024; glds_s(kt_, kof, kd_); glds_s(kt_ + 32 * ldk1 * 2, kof, kd_ + 8192); \
    if constexpr (DQK == 192) glds_s((const char*)K2 + (size_t)(t) * KVBLK * 128, k2of, ldsb + P_OFF_K2 + (b) * SHM_K2D + widu * 1024); \
    _Pragma("unroll") for (int h_ = 0; h_ < NVH; ++h_) { const unsigned vd_ = ldsb + P_OFF_V + (b) * SHM_VX + h_ * 16384 + widu * 1024; \
        glds_s(vt_ + (size_t)h_ * (SEQ * 256), vof, vd_); glds_s(vt_ + 32 * ldv * 2 + (size_t)h_ * (SEQ * 256), vof, vd_ + 8192); } } while (0)
#define BARV() do { asm volatile("s_waitcnt vmcnt(0) lgkmcnt(0)" ::: "memory"); __builtin_amdgcn_s_barrier(); asm volatile("" ::: "memory"); } while (0)
#define TCLS(t, TB, SL) do { if constexpr (BIAS) { const unsigned cw_ = (unsigned)__builtin_amdgcn_readlane((int)cls_pack, (t) >> 2); const unsigned c_ = (cw_ >> (2 * ((t) & 3))) & 3u; \
    SL = (c_ == 2u); TB = (c_ == 1u) ? bpos2 : bneg2; } else { SL = false; TB = 0.f; } } while (0)
    const int NT = seq / KVBLK;
    if (widu >= 4) __builtin_amdgcn_s_setprio(1);
    DMA(0, 0); BARV();
    f32x16 p0, p1, negm = {}; float al, tbx, negv = 0.f; bool slx; bf16x8 pa0, pa1, pa2, pa3;
    auto tile = [&](auto BC, const int j) __attribute__((always_inline)) {
        constexpr bool CB = true;
        const int b = CB ? decltype(BC)::value : (j & 1);
        TCLS(j, tbx, slx);
        const bool chk = ((j & 7) == 0) || slx;
        float cmx = 1.f, offx = 0.f;
        if constexpr (NEGM) {
            { const float want = (slx ? 0.f : tbx) - m_reg;
              if (!NEGP || __builtin_expect(__any(want != negv), 0)) { negv = want;
#pragma unroll
                  for (int r = 0; r < 16; ++r) negm[r] = want; } }
            { bf16x8 a0, b0, a1, b1, a2, b2; constexpr int KO = CB ? decltype(BC)::value * SHM_KD : 0, K2O = CB ? decltype(BC)::value * SHM_K2D : 0;
              const int kbuf = kbuf0 + (CB ? 0 : b * SHM_KD), k2buf = k2buf0 + (CB ? 0 : b * SHM_K2D);
              SBAR(); qk3_rd<0, KO, K2O>(a0, b0, kbuf, krel, k2buf, k2rel); qk3_rd<1, KO, K2O>(a1, b1, kbuf, krel, k2buf, k2rel);
              qk3_steps<DQK / 16, 0, KO, K2O>(p0, p1, negm, kbuf, krel, k2buf, k2rel, qr, a0, b0, a1, b1, a2, b2); }
            if (j + 1 < NT) DMA(j + 1, b ^ 1);
            smFront<BIAS>(p0, p1, m_reg, al, slx, j == 0, posb + j * KVBLK, pq, lut, hi, chk);
        } else {
            { const f32x16 zc = {}; bf16x8 a0, b0, a1, b1, a2, b2; constexpr int KO = CB ? decltype(BC)::value * SHM_KD : 0, K2O = CB ? decltype(BC)::value * SHM_K2D : 0;
              const int kbuf = kbuf0 + (CB ? 0 : b * SHM_KD), k2buf = k2buf0 + (CB ? 0 : b * SHM_K2D);
              SBAR(); qk3_rd<0, KO, K2O>(a0, b0, kbuf, krel, k2buf, k2rel); qk3_rd<1, KO, K2O>(a1, b1, kbuf, krel, k2buf, k2rel);
              qk3_steps<DQK / 16, 0, KO, K2O>(p0, p1, zc, kbuf, krel, k2buf, k2rel, qr, a0, b0, a1, b1, a2, b2); }
            if (j + 1 < NT) DMA(j + 1, b ^ 1);
            partialSM<BIAS, true>(p0, p1, m_reg, al, C, tbx, slx, posb + j * KVBLK, pq, lut, hi, &cmx, &offx, chk);
        }
        if (chk && __any(al < 1.f)) {
            unsigned on_ = ~0u; asm volatile("" : "+s"(on_)); const int ln_ = (int)__builtin_amdgcn_mbcnt_hi(on_, __builtin_amdgcn_mbcnt_lo(on_, 0u)), hi_ = ln_ >> 5;
            if (hi_ == 0) al_l[ln_] = al; asm volatile("s_waitcnt lgkmcnt(0)" ::: "memory");
#pragma unroll
            for (int d = 0; d < 4 * NVH; ++d)
#pragma unroll
                for (int r = 0; r < 16; ++r) o[d][r] *= al_l[crow(r, hi_)]; }
        {
            constexpr int NB = 4 * NVH, EPB = 16 / NB; const int vb_ = vb0 + b * SHM_VX;
            float ps = 0.f;
#pragma unroll
            for (int r = 0; r < 16; ++r) ps += p0[r];
            pa0 = pk8r<0>(p0); pa1 = pk8r<8>(p0);
            s16x4 L[2][2], H[2][2]; const LAS unsigned char* vp_ = ldsl + P_OFF_V + b * SHM_VX + v_rd_base(lane);
#define PK(L_, H_) (bf16x8){L_[0], L_[1], L_[2], L_[3], H_[0], H_[1], H_[2], H_[3]}
#define PVBLK(B, KS0, PX, PY) do { if constexpr ((B) + 1 < NB) pv_rd2c<((B) + 1 < NB ? (B) + 1 : 0), KS0>(L[((B) + 1) & 1], H[((B) + 1) & 1], vp_); SBAR(); \
    o[B] = __builtin_amdgcn_mfma_f32_32x32x16_bf16(PX, PK(L[(B) & 1][0], H[(B) & 1][0]), o[B], 0, 0, 0); o[B] = __builtin_amdgcn_mfma_f32_32x32x16_bf16(PY, PK(L[(B) & 1][1], H[(B) & 1][1]), o[B], 0, 0, 0); SBAR(); } while (0)
#define SMCHUNK(B) do { _Pragma("unroll") for (int r_ = (B) * EPB; r_ < (B) * EPB + EPB; ++r_) { p1[r_] = __builtin_amdgcn_exp2f(NEGM ? p1[r_] : fmaf(p1[r_], cmx, offx)); ps += p1[r_]; } \
    if constexpr ((B) * EPB + EPB == 8) pa2 = pk8r<0>(p1); SBAR(); } while (0)
            SBAR(); pv_rd2c<0, 0>(L[0], H[0], vp_);
            PVBLK(0, 0, pa0, pa1); SMCHUNK(0); PVBLK(1, 0, pa0, pa1); SMCHUNK(1); PVBLK(2, 0, pa0, pa1); SMCHUNK(2); PVBLK(3, 0, pa0, pa1); SMCHUNK(3);
            if constexpr (NB == 8) { PVBLK(4, 0, pa0, pa1); SMCHUNK(4); PVBLK(5, 0, pa0, pa1); SMCHUNK(5); PVBLK(6, 0, pa0, pa1); SMCHUNK(6); PVBLK(7, 0, pa0, pa1); SMCHUNK(7); }
            pa3 = pk8r<8>(p1);
            { auto rr = __builtin_amdgcn_permlane32_swap(__float_as_uint(ps), __float_as_uint(ps), false, false); ps = __uint_as_float(rr[0]) + __uint_as_float(rr[1]); }
            l_reg = l_reg * al + ps;
            SBAR(); pv_rd2c<0, 2>(L[0], H[0], vp_);
            PVBLK(0, 2, pa2, pa3); PVBLK(1, 2, pa2, pa3); PVBLK(2, 2, pa2, pa3); PVBLK(3, 2, pa2, pa3);
            if constexpr (NB == 8) { PVBLK(4, 2, pa2, pa3); PVBLK(5, 2, pa2, pa3); PVBLK(6, 2, pa2, pa3); PVBLK(7, 2, pa2, pa3); }
#undef PK
#undef PVBLK
#undef SMCHUNK
        }
        BARV();
    };
    for (int jj = 0; jj < NT; jj += 2) { tile(IC<0>{}, jj); tile(IC<1>{}, jj + 1); }
    __builtin_amdgcn_s_setprio(0);
    unsigned ones_e = ~0u; asm volatile("" : "+s"(ones_e)); int lane_e = (int)__builtin_amdgcn_mbcnt_hi(ones_e, __builtin_amdgcn_mbcnt_lo(ones_e, 0u)); asm volatile("" : "+v"(lane_e));
    const int r32e = lane_e & 31, hie = lane_e >> 5;
    if (hie == 0) li_l[r32e] = l_reg; asm volatile("s_waitcnt lgkmcnt(0)" ::: "memory");
    float rli[16];
#pragma unroll
    for (int r = 0; r < 16; ++r) rli[r] = __builtin_amdgcn_rcpf(li_l[crow(r, hie)]);
    bf16_t* stg = (bf16_t*)(lds + widu * (32 * DV * 2));
#pragma unroll
    for (int r = 0; r < 16; ++r) { const int orow = crow(r, hie);
#pragma unroll
        for (int d0 = 0; d0 < 4 * NVH; ++d0) stg[orow * DV + d0 * 32 + r32e] = (bf16_t)f2bf(o[d0][r] * rli[r]); }
    asm volatile("s_waitcnt lgkmcnt(0)" ::: "memory");
    constexpr int CPR = DV / 8, RPI = 64 / CPR;
    if constexpr (FUSE) {
        static_assert(DV == 256, "FUSE: one head = 256 value columns = 32 lanes x 8");
        const bf16_t* O0w = fa.O0 + (long)(widu * QBLK) * ldo; bf16_t* Hw = fa.Hout + (long)(widu * QBLK) * DM;
        const int ch = lane_e & 31; const float* gg = fa.g + ch * 8;
        const f32x4 g0 = *(const f32x4*)gg, g1 = *(const f32x4*)(gg + 4);
#pragma unroll 4
        for (int i = 0; i < 16; ++i) { const int row = i * 2 + (lane_e >> 5);
            const u32x4 b2 = *(const u32x4*)(stg + row * DV + ch * 8), a = *(const u32x4*)(O0w + (long)row * ldo + ch * 8);
            float d[8] = {bf_lo(a.x) - fa.lam * bf_lo(b2.x), bf_hi(a.x) - fa.lam * bf_hi(b2.x), bf_lo(a.y) - fa.lam * bf_lo(b2.y), bf_hi(a.y) - fa.lam * bf_hi(b2.y),
                          bf_lo(a.z) - fa.lam * bf_lo(b2.z), bf_hi(a.z) - fa.lam * bf_hi(b2.z), bf_lo(a.w) - fa.lam * bf_lo(b2.w), bf_hi(a.w) - fa.lam * bf_hi(b2.w)};
            float ss = 0.f;
#pragma unroll
            for (int e = 0; e < 8; ++e) ss += d[e] * d[e];
#pragma unroll
            for (int o_ = 1; o_ < 32; o_ <<= 1) ss += shfl_xor_l(ss, o_, lane_e);
            const float r = rsqrtf(ss * (1.f / 256.f) + EPS) * fa.oml;
            u32x4 w; w.x = pk2(d[0] * r * g0[0], d[1] * r * g0[1]); w.y = pk2(d[2] * r * g0[2], d[3] * r * g0[3]); w.z = pk2(d[4] * r * g1[0], d[5] * r * g1[1]); w.w = pk2(d[6] * r * g1[2], d[7] * r * g1[3]);
            *(u32x4*)(Hw + (long)row * DM + ch * 8) = w; }
    } else {
        bf16_t* Ow = Ob + (long)(widu * QBLK) * ldo;
#pragma unroll
        for (int i = 0; i < 32 / RPI; ++i) { const int row = i * RPI + lane_e / CPR, ch = lane_e % CPR; const u32x4 v = *(const u32x4*)(stg + row * DV + ch * 8); *(u32x4*)(Ow + (long)row * ldo + ch * 8) = v; }
        asm volatile("s_waitcnt vmcnt(0)" ::: "memory");
    }
    __syncthreads();
#undef DMA
#undef BARV
#undef TCLS
}
#undef SBAR
}

__device__ __forceinline__ void p0_transpose_item(const float* W, int K, int N, bf16_t* WT, LAS float* scr, int item, int lane) {
    const int nblk = N / 32, kb = item / nblk, nb = item % nblk, k0 = 64 * kb, n0 = 32 * nb;
#pragma unroll 8
    for (int i = 0; i < 32; ++i) { const int kk = 2 * i + (lane >> 5); scr[kk * 33 + (lane & 31)] = W[(size_t)(k0 + kk) * N + n0 + (lane & 31)]; }
    asm volatile("s_waitcnt lgkmcnt(0)" ::: "memory");
    const int c = lane & 7;
#pragma unroll
    for (int j = 0; j < 4; ++j) { const int n = (lane >> 3) + 8 * j; const LAS float* s = scr + (8 * c) * 33 + n;
        u32x4 o; o.x = pk2(s[0 * 33], s[1 * 33]); o.y = pk2(s[2 * 33], s[3 * 33]); o.z = pk2(s[4 * 33], s[5 * 33]); o.w = pk2(s[6 * 33], s[7 * 33]);
        *(u32x4*)(WT + (size_t)(n0 + n) * K + k0 + 8 * c) = o; }
    asm volatile("s_waitcnt lgkmcnt(0)" ::: "memory");
}

struct Args { const void* in[20]; float* out; unsigned char* ws; int ph_lo, ph_hi, coop, pad; };

__device__ __forceinline__ void norm_mod_rows(const float* __restrict__ X, const float* __restrict__ modl  , int sh_off, int sc_off, bf16_t* __restrict__ H, int gw, int NGW, int lane) {
    f32x4 v[8], nx[8];
    if (gw < MTOK) { const f32x4* xr = (const f32x4*)(X + (size_t)gw * DM) + lane;
#pragma unroll
        for (int j = 0; j < 8; ++j) v[j] = xr[64 * j]; }
    for (int m = gw; m < MTOK; m += NGW) {
        const int mn = m + NGW;
        if (mn < MTOK) { const f32x4* xn = (const f32x4*)(X + (size_t)mn * DM) + lane;
#pragma unroll
            for (int j = 0; j < 8; ++j) nx[j] = xn[64 * j]; }
        const float* mb = modl + (size_t)(m >> 14) * MODW;
        float s = 0.f;
#pragma unroll
        for (int j = 0; j < 8; ++j) s += (v[j].x * v[j].x + v[j].y * v[j].y) + (v[j].z * v[j].z + v[j].w * v[j].w);
        const float r = rsqrtf(wave_sum(s, lane) * (1.f / DM) + EPS);
        u32x2* o8 = (u32x2*)(H + (size_t)m * DM) + lane;
#pragma unroll
        for (int j = 0; j < 8; ++j) { const f32x4 sc = *((const f32x4*)(mb + sc_off) + lane + 64 * j), sh = *((const f32x4*)(mb + sh_off) + lane + 64 * j);
            const f32x4 y = (v[j] * r) * (sc + 1.0f) + sh; u32x2 w; w.x = pk2(y.x, y.y); w.y = pk2(y.z, y.w); o8[64 * j] = w; }
#pragma unroll
        for (int j = 0; j < 8; ++j) v[j] = nx[j];
    }
}

constexpr int N_PHASES = 22;
constexpr int LDS_BYTES = 160768;
static_assert(att::ATT_LDS <= LDS_BYTES && pg8::STAGE_BYTES <= LDS_BYTES && LDS_BYTES <= 163840, "LDS map");
typedef const __attribute__((address_space(4))) Args* KArgs;
#define PHASE_IDS() KArgs ka = (KArgs)__builtin_amdgcn_kernarg_segment_ptr(); asm volatile("" : "+s"(ka)); unsigned char* const ws = ka->ws; float* const out = ka->out; \
    unsigned ones_ = ~0u; asm volatile("" : "+s"(ones_)); int lane = (int)__builtin_amdgcn_mbcnt_hi(ones_, __builtin_amdgcn_mbcnt_lo(ones_, 0u)); asm volatile("" : "+v"(lane)); int vcu_o = vcu; asm volatile("" : "+s"(vcu_o)); const int tid = wave * 64 + lane, gw = vcu_o * 8 + wave; (void)gw; (void)ws; (void)out
#define IN_F(k) ((const float*)ka->in[k])
#define WSP(T, off) ((T*)(ws + (off)))
__global__ void __launch_bounds__(512, 2) mk_fwd(Args args) {
    extern __shared__ __attribute__((aligned(16))) unsigned char lds[];
    const int wave = __builtin_amdgcn_readfirstlane((int)threadIdx.x >> 6);
    const int G = gridDim.x, bx = blockIdx.x; const int vcu = ((G & 7) == 0) ? (bx & 7) * (G >> 3) + (bx >> 3) : bx;
    const int NGW = G * 8;
    LAS unsigned char* ldsl = (LAS unsigned char*)lds;
    const int lo = args.ph_lo, hi = args.ph_hi, coop = args.coop;
#define IN(k) (lo <= (k) && (k) < hi)
#define SEAM(k) do { if (IN((k) + 1) && coop) { cg::this_grid().sync(); } } while (0)

    if (IN(0)) {
        PHASE_IDS();
        {
            const float* cvec = IN_F(1); const float* w_ada = IN_F(4); const float* b_ada = IN_F(5); float* MOD = WSP(float, CTL_MOD);
            LAS float* cs = (LAS float*)ldsl; LAS float* red = (LAS float*)(ldsl + 16384);
            for (int t = tid; t < BATCH * DM; t += 512) { const float c = cvec[t]; cs[t] = c / (1.f + __expf(-c)); }
            __syncthreads();
            for (int item = bx; item < 768; item += G) {
                const int l = item / 384, j0 = (item % 384) * 32, colq = tid & 7, ks = tid >> 3;
                const float* W = w_ada + (size_t)l * DM * MODW + j0 + colq * 4;
                f32x4 a0 = {0.f, 0.f, 0.f, 0.f}, a1 = {0.f, 0.f, 0.f, 0.f};
#pragma unroll 8
                for (int k = ks; k < DM; k += 64) { const f32x4 w = *(const f32x4*)(W + (size_t)k * MODW); a0 += w * cs[k]; a1 += w * cs[DM + k]; }
                LAS f32x4* rp = (LAS f32x4*)(red + (ks * 8 + colq) * 8); rp[0] = a0; rp[1] = a1;
                __syncthreads();
                if (tid < 64) { const int b = tid >> 5, c = tid & 31; float s = 0.f;
                    for (int k2 = 0; k2 < 64; ++k2) s += red[(k2 * 8 + (c >> 2)) * 8 + b * 4 + (c & 3)];
                    MOD[(size_t)(l * 2 + b) * MODW + j0 + c] = s + b_ada[(size_t)l * MODW + j0 + c]; }
                __syncthreads();
            }
        }
        {
            const int* positions = (const int*)ka->in[2]; const float* rel_bias = IN_F(3);
            const float* lq1 = IN_F(7); const float* lk1 = IN_F(8); const float* lq2 = IN_F(9); const float* lk2 = IN_F(10);
            float* LUT = WSP(float, CTL_LUT); float* LAM = WSP(float, CTL_LAM); int* PMM = WSP(int, CTL_PMM); float* ROPE = WSP(float, WS_ROPE); bf16_t* WIN = WSP(bf16_t, WS_WIN);
            const int gt = vcu * 512 + tid, NGT = G * 512;
            for (int i = gt; i < 4 * 257; i += NGT) { const int h = i / 257, idx = i % 257, rel = idx - 128, n = rel < 0 ? -rel : rel;
                int bk = n; if (n >= 8) { bk = 8 + (n >= 12) + (n >= 16) + (n >= 23) + (n >= 32) + (n >= 46) + (n >= 64) + (n >= 91); }
                if (rel > 0) bk += 16;
                LUT[i] = rel_bias[bk * 4 + h] * LOG2E; }
            if (gt < DEPTH) { const int l = gt; float s1 = 0.f, s2 = 0.f;
                for (int i = 0; i < 128; ++i) { s1 += lq1[l * 128 + i] * lk1[l * 128 + i]; s2 += lq2[l * 128 + i] * lk2[l * 128 + i]; }
                const float li = 0.8f - 0.6f * expf(-0.3f * (float)l);
                LAM[l] = expf(s1) - expf(s2) + li; LAM[2 + l] = 1.f - li; }
            for (int g = gt; g < MTOK / 32; g += NGT) { int mn = 0x7fffffff, mx = (int)0x80000000;
                for (int i = 0; i < 32; ++i) { const int p = positions[g * 32 + i]; mn = p < mn ? p : mn; mx = p > mx ? p : mx; }
                PMM[2 * g] = mn; PMM[2 * g + 1] = mx; }
            for (int i = gt; i < MTOK * 32; i += NGT) { const int m = i >> 5, f = i & 31;
                const float ang = (float)positions[m] * INV_FREQ[f];
                const double rev = (double)ang * 0.15915494309189535; const float fr = (float)(rev - __builtin_floor(rev));
                ((f32x2*)ROPE)[i] = (f32x2){__builtin_amdgcn_cosf(fr), __builtin_amdgcn_sinf(fr)}; }
            for (int i = gt; i < DEPTH * (IN_PAD - IN_COLS) * DM / 8; i += NGT) { const int l = i / ((IN_PAD - IN_COLS) * DM / 8), r = i % ((IN_PAD - IN_COLS) * DM / 8);
                *(u32x4*)(WIN + (size_t)l * IN_PAD * DM + (size_t)IN_COLS * DM + (size_t)r * 8) = (u32x4){0u, 0u, 0u, 0u}; }
        }
        __syncthreads();
        {
            LAS float* scr = (LAS float*)(ldsl + wave * 16384);
            constexpr int I_IN = (DM / 64) * (IN_COLS / 32), I_UQ = (QL / 64) * (NQM / 32), I_UKV = (KVL / 64) * (NKV / 32), I_O = (DM / 64) * (DM / 32), I_1 = (DM / 64) * (DFF / 32), I_2 = (DFF / 64) * (DM / 32);
            constexpr int PER_L = I_IN + I_UQ + I_UKV + I_O + I_1 + I_2;
            for (int it = gw; it < DEPTH * PER_L; it += NGW) {
                const int l = it / PER_L; int r = it % PER_L;
                if (r < I_IN) { p0_transpose_item(IN_F(6) + (size_t)l * DM * IN_COLS, DM, IN_COLS, WSP(bf16_t, WS_WIN) + (size_t)l * IN_PAD * DM, scr, r, lane); continue; } r -= I_IN;
                if (r < I_UQ) { p0_transpose_item(IN_F(13) + (size_t)l * QL * NQM, QL, NQM, WSP(bf16_t, WS_WUQ) + (size_t)l * NQM * QL, scr, r, lane); continue; } r -= I_UQ;
                if (r < I_UKV) { p0_transpose_item(IN_F(15) + (size_t)l * KVL * NKV, KVL, NKV, WSP(bf16_t, WS_WUKV) + (size_t)l * NKV * KVL, scr, r, lane); continue; } r -= I_UKV;
                if (r < I_O) { p0_transpose_item(IN_F(16) + (size_t)l * DM * DM, DM, DM, WSP(bf16_t, WS_WO) + (size_t)l * DM * DM, scr, r, lane); continue; } r -= I_O;
                if (r < I_1) { p0_transpose_item(IN_F(17) + (size_t)l * DM * DFF, DM, DFF, WSP(bf16_t, WS_W1) + (size_t)l * DFF * DM, scr, r, lane); continue; } r -= I_1;
                p0_transpose_item(IN_F(18) + (size_t)l * DFF * DM, DFF, DM, WSP(bf16_t, WS_W2) + (size_t)l * DM * DFF, scr, r, lane);
            }
        }
        __syncthreads();
        SEAM(0);
    }

    for (int l = 0; l < DEPTH; ++l) {
        const int pb = 1 + 10 * l;
        if (IN(pb + 0)) { PHASE_IDS(); norm_mod_rows((l == 0) ? IN_F(0) : out, WSP(float, CTL_MOD) + (size_t)l * 2 * MODW, 0 * DM, 1 * DM, WSP(bf16_t, WS_HB), gw, NGW, lane); SEAM(pb + 0); }
        if (IN(pb + 1)) {
            PHASE_IDS();
            pg8::Gemm g{WSP(bf16_t, WS_HB), WSP(bf16_t, WS_WIN) + (size_t)l * IN_PAD * DM, MTOK, IN_PAD, DM}; pg8::StaticOrder S; S.init(MTOK, IN_PAD, G, bx);
            pg8::EpiBf16<0, true> E{WSP(bf16_t, WS_PROJ), IN_PAD / 128};
            pg8::gemm_phase<pg8::EpiBf16<0, true>, pg8::StaticOrder, true, true>(ldsl, g, S, E, tid);
            SEAM(pb + 1);
        }
        if (IN(pb + 2)) {
            PHASE_IDS();
            const bf16_t* PROJ = WSP(bf16_t, WS_PROJ); bf16_t* CQN = WSP(bf16_t, WS_CQN); bf16_t* CKVN = WSP(bf16_t, WS_CKVN); bf16_t* KROPE = WSP(bf16_t, WS_KROPE);
            const float* ROPE = WSP(float, WS_ROPE); const float* qn_g = IN_F(12); const float* kvn_g = IN_F(14);
            for (int m = gw; m < MTOK; m += NGW) {
                const int bb = m >> 14, ss = m & 16383;
#define PH(head) (PROJ + ((size_t)(bb * 32 + (head)) * SEQ + ss) * 128)
                { const u32x4 w = *((const u32x4*)PH(24 + (lane >> 4)) + (lane & 15)); float v[8] = {bf_lo(w.x), bf_hi(w.x), bf_lo(w.y), bf_hi(w.y), bf_lo(w.z), bf_hi(w.z), bf_lo(w.w), bf_hi(w.w)};
                  float s = 0.f;
#pragma unroll
                  for (int e = 0; e < 8; ++e) s += v[e] * v[e];
                  const float r = rsqrtf(wave_sum(s, lane) * (1.f / QL) + EPS); const float* gq = qn_g + l * QL + lane * 8;
                  u32x4 o; o.x = pk2(v[0] * r * gq[0], v[1] * r * gq[1]); o.y = pk2(v[2] * r * gq[2], v[3] * r * gq[3]); o.z = pk2(v[4] * r * gq[4], v[5] * r * gq[5]); o.w = pk2(v[6] * r * gq[6], v[7] * r * gq[7]);
                  *((u32x4*)(CQN + (size_t)m * QL) + lane) = o; }
                { const u32x2 w = *((const u32x2*)PH(28 + (lane >> 5)) + (lane & 31)); float v[4] = {bf_lo(w.x), bf_hi(w.x), bf_lo(w.y), bf_hi(w.y)};
                  float s = (v[0] * v[0] + v[1] * v[1]) + (v[2] * v[2] + v[3] * v[3]);
                  const float r = rsqrtf(wave_sum(s, lane) * (1.f / KVL) + EPS); const float* gk = kvn_g + l * KVL + lane * 4;
                  u32x2 o; o.x = pk2(v[0] * r * gk[0], v[1] * r * gk[1]); o.y = pk2(v[2] * r * gk[2], v[3] * r * gk[3]);
                  *((u32x2*)(CKVN + (size_t)m * KVL) + lane) = o; }
                { const float xv = __builtin_bit_cast(float, (unsigned)PH(30)[lane] << 16); const float xo = shfl_xor_l(xv, 32, lane);
                  const f32x2 cs = ((const f32x2*)ROPE)[(size_t)m * 32 + (lane & 31)];
                  const float y = (lane < 32) ? (xv * cs.x - xo * cs.y) : (xv * cs.x + xo * cs.y);
                  KROPE[(size_t)m * 64 + lane] = (bf16_t)f2bf(y); }
#undef PH
            }
            SEAM(pb + 2);
        }
        if (IN(pb + 3)) {
            PHASE_IDS();
            { pg8::Gemm g{WSP(bf16_t, WS_CQN), WSP(bf16_t, WS_WUQ) + (size_t)l * NQM * QL, MTOK, NQM, QL}; pg8::StaticOrder S; S.init(MTOK, NQM, G, bx);
              pg8::EpiBf16<0> E{WSP(bf16_t, WS_QM), NQM}; pg8::gemm_phase<pg8::EpiBf16<0>, pg8::StaticOrder, true, true>(ldsl, g, S, E, tid); }
            { pg8::Gemm g{WSP(bf16_t, WS_CKVN), WSP(bf16_t, WS_WUKV) + (size_t)l * NKV * KVL, MTOK, NKV, KVL}; pg8::StaticOrder S; S.init(MTOK, NKV, G, bx);
              pg8::EpiBf16<0, true> E{WSP(bf16_t, WS_KV), NKV / 128}; pg8::gemm_phase<pg8::EpiBf16<0, true>, pg8::StaticOrder, true, true>(ldsl, g, S, E, tid); }
            SEAM(pb + 3);
        }
        if (IN(pb + 4)) {
            for (int rep = 0; rep < ((PROBE_DUP & 1) ? 2 : 1); ++rep)
            for (int t = vcu; t < 16 * 64; t += G) {
                PHASE_IDS();
                const int mg = t >> 6, qb = t & 63, b = mg >> 3, h = mg & 7; const size_t r0 = (size_t)b * SEQ;
                const bf16_t* QM = WSP(bf16_t, WS_QM); const bf16_t* KV = WSP(bf16_t, WS_KV);
                att::attn_unit_dma<192, 128, false>(QM + (r0 + qb * 256) * NQM + h * 192, NQM, KV + (size_t)(b * 16 + 2 * h) * SEQ * 128, 128, WSP(bf16_t, WS_KROPE) + r0 * 64, KV + (size_t)(b * 16 + 2 * h + 1) * SEQ * 128, 128,
                                           WSP(bf16_t, WS_HB) + (r0 + qb * 256) * DM + 1024 + h * 128, DM, WSP(float, WS_ROPE) + (r0 + qb * 256) * 64, nullptr, nullptr, 0, nullptr,
                                           0.07216878364870323f * LOG2E, SEQ, (char*)lds, ldsl, tid);
            }
            for (int t = vcu; t < 8 * 64; t += G) {
                const int dgp = t >> 6, qb = t & 63, b = dgp >> 2, h = dgp & 3; const size_t r0 = (size_t)b * SEQ;
                { PHASE_IDS();
                  const bf16_t* PROJ = WSP(bf16_t, WS_PROJ);
                  att::attn_unit_dma<128, 256, true>(PROJ + ((size_t)(b * 32 + h * 2 + 0) * SEQ + qb * 256) * 128, 128, PROJ + (size_t)(b * 32 + 8 + h * 2 + 0) * SEQ * 128, 128, nullptr,
                                          PROJ + (size_t)(b * 32 + 16 + h * 2) * SEQ * 128, 128, WSP(bf16_t, WS_ODIFF) + (r0 + qb * 256) * 2048 + h * 256, 2048,
                                          nullptr, (const int*)ka->in[2] + r0, WSP(int, CTL_PMM) + (r0 >> 5) * 2, qb * 256, WSP(float, CTL_LUT) + h * 257, 0.08838834764831845f * LOG2E, SEQ, (char*)lds, ldsl, tid); }
                { PHASE_IDS();
                  const bf16_t* PROJ = WSP(bf16_t, WS_PROJ); const float* LAM = WSP(float, CTL_LAM);
                  const att::FuseArgs fa{WSP(bf16_t, WS_ODIFF) + (r0 + qb * 256) * 2048 + h * 256, WSP(bf16_t, WS_HB) + (r0 + qb * 256) * DM + h * 256, IN_F(11) + l * 256, LAM[l], LAM[2 + l]};
                  att::attn_unit_dma<128, 256, true, true>(PROJ + ((size_t)(b * 32 + h * 2 + 1) * SEQ + qb * 256) * 128, 128, PROJ + (size_t)(b * 32 + 8 + h * 2 + 1) * SEQ * 128, 128, nullptr,
                                          PROJ + (size_t)(b * 32 + 16 + h * 2) * SEQ * 128, 128, nullptr, 2048,
                                          nullptr, (const int*)ka->in[2] + r0, WSP(int, CTL_PMM) + (r0 >> 5) * 2, qb * 256, WSP(float, CTL_LUT) + h * 257, 0.08838834764831845f * LOG2E, SEQ, (char*)lds, ldsl, tid, fa); }
            }
            SEAM(pb + 4);
        }
        if (IN(pb + 6)) {
            PHASE_IDS();
            pg8::Gemm g{WSP(bf16_t, WS_HB), WSP(bf16_t, WS_WO) + (size_t)l * DM * DM, MTOK, DM, DM}; pg8::StaticOrder S; S.init(MTOK, DM, G, bx);
            pg8::EpiRes E{(l == 0) ? IN_F(0) : out, out, WSP(float, CTL_MOD) + (size_t)l * 2 * MODW + 2 * DM, MODW, DM};
            pg8::gemm_phase<pg8::EpiRes, pg8::StaticOrder, true, true>(ldsl, g, S, E, tid);
            SEAM(pb + 6);
        }
        if (IN(pb + 7)) { PHASE_IDS(); norm_mod_rows(out, WSP(float, CTL_MOD) + (size_t)l * 2 * MODW, 3 * DM, 4 * DM, WSP(bf16_t, WS_HB), gw, NGW, lane); SEAM(pb + 7); }
        if (IN(pb + 8)) {
            PHASE_IDS();
            pg8::Gemm g{WSP(bf16_t, WS_HB), WSP(bf16_t, WS_W1) + (size_t)l * DFF * DM, MTOK, DFF, DM}; pg8::StaticOrder S; S.init(MTOK, DFF, G, bx);
            pg8::EpiBf16<2> E{WSP(bf16_t, WS_U), DFF};
            for (int rep = 0; rep < ((PROBE_DUP & 4) ? 2 : 1); ++rep)
            pg8::gemm_phase<pg8::EpiBf16<2>, pg8::StaticOrder, true, true>(ldsl, g, S, E, tid);
            SEAM(pb + 8);
        }
        if (IN(pb + 9)) {
            PHASE_IDS();
            pg8::Gemm g{WSP(bf16_t, WS_U), WSP(bf16_t, WS_W2) + (size_t)l * DM * DFF, MTOK, DM, DFF}; pg8::StaticOrder S; S.init(MTOK, DM, G, bx);
            pg8::EpiRes E{out, out, WSP(float, CTL_MOD) + (size_t)l * 2 * MODW + 5 * DM, MODW, DM};
            pg8::gemm_phase<pg8::EpiRes, pg8::StaticOrder, true, true>(ldsl, g, S, E, tid);
            SEAM(pb + 9);
        }
    }
    if (IN(21)) {
        PHASE_IDS();
        const float* fin_g = IN_F(19);
        for (int m = gw; m < MTOK; m += NGW) {
            f32x4* xr = (f32x4*)(out + (size_t)m * DM) + lane; f32x4 v[8]; float s = 0.f;
#pragma unroll
            for (int j = 0; j < 8; ++j) { v[j] = xr[64 * j]; s += (v[j].x * v[j].x + v[j].y * v[j].y) + (v[j].z * v[j].z + v[j].w * v[j].w); }
            const float r = rsqrtf(wave_sum(s, lane) * (1.f / DM) + EPS);
#pragma unroll
            for (int j = 0; j < 8; ++j) { const f32x4 gg = *((const f32x4*)fin_g + lane + 64 * j); xr[64 * j] = (v[j] * r) * gg; }
        }
    }
#undef IN
#undef SEAM
}

extern "C" void kernel_launch(void* const* d_in, const int* in_sizes, int n_in, void* d_out, int out_size, void* d_ws, size_t ws_size, hipStream_t stream) {
    static int grid = 0;
    if (grid == 0) {
        if (n_in != 20 || out_size != MTOK * DM || ws_size < WS_END) { fprintf(stderr, "kernel_launch: unexpected shapes (n_in %d out %d ws %zu, need ws >= %zu)\n", n_in, out_size, ws_size, (size_t)WS_END); }
        int dev = 0, cus = 0, per_cu = 0;
        (void)hipGetDevice(&dev); (void)hipDeviceGetAttribute(&cus, hipDeviceAttributeMultiprocessorCount, dev);
        if (hipFuncSetAttribute((const void*)mk_fwd, hipFuncAttributeMaxDynamicSharedMemorySize, LDS_BYTES) != hipSuccess) fprintf(stderr, "kernel_launch: hipFuncSetAttribute failed\n");
        if (hipOccupancyMaxActiveBlocksPerMultiprocessor(&per_cu, (const void*)mk_fwd, 512, LDS_BYTES) != hipSuccess || per_cu < 1) { fprintf(stderr, "kernel_launch: occupancy query says %d\n", per_cu); per_cu = 1; }
        (void)hipGetLastError();
        grid = cus > 0 ? cus : 256;
    }
    Args a{};
    for (int i = 0; i < 20; ++i) a.in[i] = d_in[i];
    a.out = (float*)d_out; a.ws = (unsigned char*)d_ws;
#if MK_N_LAUNCHES == 1
    a.ph_lo = 0; a.ph_hi = N_PHASES; a.coop = 1;
    void* kargs[] = {&a};
    hipError_t e = hipLaunchCooperativeKernel((const void*)mk_fwd, dim3(grid), dim3(512), kargs, LDS_BYTES, stream);
    if (e != hipSuccess) fprintf(stderr, "kernel_launch: cooperative launch failed: %s (grid %d)\n", hipGetErrorString(e), grid);
#else
    for (int p = 0; p < N_PHASES; ++p) {
        a.ph_lo = p; a.ph_hi = p + 1; a.coop = 0;
        hipLaunchKernelGGL(mk_fwd, dim3(grid), dim3(512), LDS_BYTES, stream, a);
    }
    const hipError_t le = hipPeekAtLastError();
    if (le != hipSuccess) fprintf(stderr, "kernel_launch: launch failed: %s\n", hipGetErrorName(le));
#endif
}
```
